# Optimizing an MI355X kernel written in HIP

```python
import jax, jax.numpy as jnp
from jax import lax
import numpy as np

D_MODEL = 1024
BATCH = 4
SEQ = 8192
DEPTH = 1

GRID_W = 64
CTX_LEN = 256
HEAD_DIM = 64
ATTN_HEADS = 8
ATTN_KV_HEADS = 2
GQA_GROUP = ATTN_HEADS // ATTN_KV_HEADS
RET_HEADS = 8
ATTN_WIDTH = ATTN_HEADS * HEAD_DIM
KV_WIDTH = ATTN_KV_HEADS * HEAD_DIM
RET_WIDTH = RET_HEADS * HEAD_DIM
MIX_WIDTH = ATTN_WIDTH + RET_WIDTH
IN_PROJ_WIDTH = ATTN_WIDTH + 2 * KV_WIDTH + 4 * RET_WIDTH
SPLITS = (ATTN_WIDTH, ATTN_WIDTH + KV_WIDTH, ATTN_WIDTH + 2 * KV_WIDTH,
          ATTN_WIDTH + 2 * KV_WIDTH + RET_WIDTH, ATTN_WIDTH + 2 * KV_WIDTH + 2 * RET_WIDTH,
          ATTN_WIDTH + 2 * KV_WIDTH + 3 * RET_WIDTH)
FFN_HIDDEN = -(-8 * D_MODEL // (3 * 256)) * 256
N_MOD = 6
QBLOCK = 128
RET_CHUNK = 128
ROPE_BASE = 10000.0
ATTN_SCALE = HEAD_DIM ** -0.5
EPS = 1e-6

kernel_name = 'hybrid_gqa_retention_dit_block'


def rms_norm(x, g):
    xf = x.astype(jnp.float32)
    y = xf * lax.rsqrt(jnp.mean(xf * xf, axis=-1, keepdims=True) + EPS)
    return (y * g.astype(jnp.float32)).astype(x.dtype)


def head_group_norm(o):
    mu = jnp.mean(o, axis=-1, keepdims=True)
    var = jnp.mean(jnp.square(o - mu), axis=-1, keepdims=True)
    return (o - mu) * lax.rsqrt(var + EPS)


def modulate(h, shift, scale):
    return h * (1 + scale) + shift


def axial_rope(rows):
    row = jnp.broadcast_to(jnp.arange(rows)[:, None], (rows, GRID_W)).reshape(-1).astype(jnp.float32)
    col = jnp.broadcast_to(jnp.arange(GRID_W)[None, :], (rows, GRID_W)).reshape(-1).astype(jnp.float32)
    n_freq = HEAD_DIM // 4
    inv = ROPE_BASE ** (-jnp.arange(n_freq, dtype=jnp.float32) / n_freq)
    ang = jnp.concatenate([row[:, None] * inv, col[:, None] * inv], axis=-1)
    return jnp.cos(ang), jnp.sin(ang)


def apply_rope(x, cos, sin):
    half = HEAD_DIM // 2
    x1, x2 = x[..., :half], x[..., half:]
    c, s = cos[None, :, None, :], sin[None, :, None, :]
    return jnp.concatenate([x1 * c - x2 * s, x1 * s + x2 * c], axis=-1).astype(x.dtype)


def project(h, w_in, q_norm_g, k_norm_g):
    B, N, _ = h.shape
    qa, ka, va, qr, kr, vr, gr = jnp.split(h @ w_in, SPLITS, axis=-1)
    heads = lambda a: a.reshape(B, N, -1, HEAD_DIM)
    qa = rms_norm(heads(qa), q_norm_g)
    ka = rms_norm(heads(ka), k_norm_g)
    return qa, ka, heads(va), heads(qr), heads(kr) * ATTN_SCALE, heads(vr), gr


def gqa_block(q, k, v):
    B, Q = q.shape[:2]
    qg = q.reshape(B, Q, ATTN_KV_HEADS, GQA_GROUP, HEAD_DIM)
    s = jnp.einsum('bqkgd,btkd->bkgqt', qg, k, preferred_element_type=jnp.float32) * ATTN_SCALE
    p = jax.nn.softmax(s, axis=-1).astype(v.dtype)
    o = jnp.einsum('bkgqt,btkd->bqkgd', p, v)
    return o.reshape(B, Q, ATTN_WIDTH)


def latent_attention(q, k_lat, v_lat, k_ctx, v_ctx):
    B, N = q.shape[:2]
    k_all = jnp.concatenate([k_ctx, k_lat], axis=1)
    v_all = jnp.concatenate([v_ctx, v_lat], axis=1)
    qb = q.reshape(B, N // QBLOCK, QBLOCK, ATTN_HEADS, HEAD_DIM).swapaxes(0, 1)
    o = lax.map(lambda qi: gqa_block(qi, k_all, v_all), qb)
    return o.swapaxes(0, 1).reshape(B, N, ATTN_WIDTH)


def retention_chunkwise(q, k, v, log_gamma, state0):
    B, N, H, d = q.shape
    C = RET_CHUNK
    nc = N // C
    lg = log_gamma.astype(jnp.float32)
    chunks = lambda a: a.astype(jnp.float32).reshape(B, nc, C, H, d).transpose(1, 0, 3, 2, 4)
    pos = jnp.arange(C, dtype=jnp.float32)
    diff = pos[:, None] - pos[None, :]
    decay_mat = jnp.where(diff >= 0, jnp.exp(lg[:, None, None] * jnp.maximum(diff, 0.0)), 0.0)
    q_decay = jnp.exp(lg[:, None] * (pos + 1.0))[..., None]
    k_decay = jnp.exp(lg[:, None] * (C - 1.0 - pos))[..., None]
    chunk_decay = jnp.exp(lg * C)[:, None, None]

    def step(state, qkv):
        qc, kc, vc = qkv
        inner = jnp.einsum('bhid,bhjd->bhij', qc, kc) * decay_mat
        o = jnp.einsum('bhij,bhjd->bhid', inner, vc) + jnp.einsum('bhid,bhde->bhie', qc, state) * q_decay
        state = state * chunk_decay + jnp.einsum('bhjd,bhje->bhde', kc * k_decay, vc)
        return state, o

    state, o = lax.scan(step, state0.astype(jnp.float32), (chunks(q), chunks(k), chunks(v)))
    return o.transpose(1, 0, 3, 2, 4).reshape(B, N, H, d), state


def bidir_retention(q, k, v, lg_f, lg_b, state_f, state_b):
    o_f, s_f = retention_chunkwise(q, k, v, lg_f, state_f)
    o_b, s_b = retention_chunkwise(q[:, ::-1], k[:, ::-1], v[:, ::-1], lg_b, state_b)
    return o_f + o_b[:, ::-1], s_f, s_b


def merge_heads(att, ret, g_r, w_out):
    B, N = att.shape[:2]
    ret = head_group_norm(ret).reshape(B, N, RET_WIDTH).astype(g_r.dtype) * jax.nn.silu(g_r)
    return jnp.concatenate([att, ret], axis=-1) @ w_out


def swiglu(h, w_ffn_in, w_ffn_out):
    a, b = jnp.split(h @ w_ffn_in, 2, axis=-1)
    return (jax.nn.silu(a) * b) @ w_ffn_out


def setup_inputs(seed: int = 0) -> dict:
    key = jax.random.key(seed)
    ks = jax.random.split(key, 18)
    D = D_MODEL
    nrm = lambda k, shape: jax.random.normal(k, shape, jnp.float32)
    w = lambda k, shape, fan_in, g=1.0: nrm(k, shape) * (g * fan_in ** -0.5)
    gain = lambda k, shape: 1.0 + 0.05 * nrm(k, shape)
    gammas = 1.0 - 2.0 ** (-5.0 - jnp.arange(RET_HEADS, dtype=jnp.float32))
    base = jnp.log(-jnp.log(gammas))
    return {
        'x': nrm(ks[0], (BATCH, SEQ, D)),
        'c': nrm(ks[1], (BATCH, D)),
        'ctx': nrm(ks[2], (BATCH, CTX_LEN, D)),
        'c_ctx': nrm(ks[3], (D,)),
        'w_mod': w(ks[4], (DEPTH, D, N_MOD * D), D, 0.5),
        'b_mod': 0.02 * nrm(ks[5], (DEPTH, N_MOD * D)),
        'g_pre_mix': gain(ks[6], (DEPTH, D)),
        'g_post_mix': gain(ks[7], (DEPTH, D)),
        'g_pre_ffn': gain(ks[8], (DEPTH, D)),
        'g_post_ffn': gain(ks[9], (DEPTH, D)),
        'w_in': w(ks[10], (DEPTH, D, IN_PROJ_WIDTH), D),
        'q_norm_g': gain(ks[11], (DEPTH, HEAD_DIM)),
        'k_norm_g': gain(ks[12], (DEPTH, HEAD_DIM)),
        'ret_decay_fwd': base + 0.1 * nrm(ks[13], (DEPTH, RET_HEADS)),
        'ret_decay_bwd': base + 0.1 * nrm(ks[14], (DEPTH, RET_HEADS)),
        'w_out': w(ks[15], (DEPTH, MIX_WIDTH, D), MIX_WIDTH),
        'w_ffn_in': w(ks[16], (DEPTH, D, 2 * FFN_HIDDEN), D),
        'w_ffn_out': w(ks[17], (DEPTH, FFN_HIDDEN, D), FFN_HIDDEN),
    }


def reference(x, c, ctx, c_ctx, w_mod, b_mod, g_pre_mix, g_post_mix, g_pre_ffn, g_post_ffn,
              w_in, q_norm_g, k_norm_g, ret_decay_fwd, ret_decay_bwd, w_out, w_ffn_in, w_ffn_out):
    B, n_lat, _ = x.shape
    rows = n_lat // GRID_W
    cos, sin = axial_rope(rows)
    for layer in range(DEPTH):
        mod_x = (jax.nn.silu(c) @ w_mod[layer] + b_mod[layer])[:, None, :]
        mod_c = jax.nn.silu(c_ctx) @ w_mod[layer] + b_mod[layer]
        sh_m, sc_m, gt_m, sh_f, sc_f, gt_f = jnp.split(mod_x, N_MOD, axis=-1)
        csh_m, csc_m, cgt_m, csh_f, csc_f, cgt_f = jnp.split(mod_c, N_MOD, axis=-1)
        lg_f = -jnp.exp(ret_decay_fwd[layer].astype(jnp.float32))
        lg_b = -jnp.exp(ret_decay_bwd[layer].astype(jnp.float32))

        hx = modulate(rms_norm(x, g_pre_mix[layer]), sh_m, sc_m)
        hc = modulate(rms_norm(ctx, g_pre_mix[layer]), csh_m, csc_m)
        qa_x, ka_x, va_x, qr_x, kr_x, vr_x, gr_x = project(hx, w_in[layer], q_norm_g[layer], k_norm_g[layer])
        qa_c, ka_c, va_c, qr_c, kr_c, vr_c, gr_c = project(hc, w_in[layer], q_norm_g[layer], k_norm_g[layer])

        zero_state = jnp.zeros((B, RET_HEADS, HEAD_DIM, HEAD_DIM), jnp.float32)
        ret_c, st_f, st_b = bidir_retention(qr_c, kr_c, vr_c, lg_f, lg_b, zero_state, zero_state)

        att_x = latent_attention(apply_rope(qa_x, cos, sin), apply_rope(ka_x, cos, sin), va_x, ka_c, va_c)
        ret_x, _, _ = bidir_retention(apply_rope(qr_x, cos, sin), apply_rope(kr_x, cos, sin), vr_x,
                                      lg_f, lg_b, st_f, st_b)
        mix_x = merge_heads(att_x, ret_x, gr_x, w_out[layer])
        x_new = x + gt_m * rms_norm(mix_x, g_post_mix[layer])
        hf = modulate(rms_norm(x_new, g_pre_ffn[layer]), sh_f, sc_f)
        x_new = x_new + gt_f * rms_norm(swiglu(hf, w_ffn_in[layer], w_ffn_out[layer]), g_post_ffn[layer])

        if layer < DEPTH - 1:
            att_c = gqa_block(qa_c, ka_c, va_c)
            mix_c = merge_heads(att_c, ret_c, gr_c, w_out[layer])
            ctx = ctx + cgt_m * rms_norm(mix_c, g_post_mix[layer])
            hfc = modulate(rms_norm(ctx, g_pre_ffn[layer]), csh_f, csc_f)
            ctx = ctx + cgt_f * rms_norm(swiglu(hfc, w_ffn_in[layer], w_ffn_out[layer]), g_post_ffn[layer])
        x = x_new
    return x
```

```cpp
#include <hip/hip_runtime.h>
#include <hip/hip_cooperative_groups.h>
#include <hip/hip_bf16.h>
#include <cstdio>
#include <cstdint>
#include <cmath>
namespace cg = cooperative_groups;
namespace pg8 {
#define PG8_LAS __attribute__((address_space(3)))
typedef unsigned short bf16_t;
typedef short bf16x8 __attribute__((ext_vector_type(8)));
typedef float f32x4 __attribute__((ext_vector_type(4)));
typedef unsigned u32x4 __attribute__((ext_vector_type(4)));
constexpr int BM = 256, BK = 64, HALF = 128, HTB = HALF * BK * 2  , STAGE_BYTES = 8 * HTB, NXCD = 8, WGM = 8;

__host__ __device__ __forceinline__ int lds_byte(int r, int c) { const int st = (r >> 4) * 2 + (c >> 5), rr = r & 15, cc = c & 31, ob = rr * 64 + cc * 2; return st * 1024 + (ob ^ (((ob >> 9) & 1) << 5)); }
__host__ __device__ __forceinline__ void stage_rc(int b, int& R, int& C) { const int st = b / 1024, sb = b % 1024, swz = sb ^ (((sb >> 9) & 1) << 5); R = (st >> 1) * 16 + swz / 64; C = (st & 1) * 32 + (swz % 64) / 2; }
__host__ __device__ __forceinline__ int perm32(int rho) { const int n = rho >> 4, i = rho & 15; return 8 * (i >> 2) + 4 * n + (i & 3); }

struct Unit { int pm, pn; };
struct Gemm { const bf16_t* A; const bf16_t* Bt; int M, N, K; };

struct StaticOrder {
    int nM, nN, nwg, G, c;
    __host__ __device__ void init(int M, int N, int G_, int c_) { nM = M / BM; nN = N / BM; nwg = nM * nN; G = G_; c = c_; }
    __host__ __device__ bool next(int i, Unit& u) const {
        const long L = (long)i * G + c; if (L >= nwg) return false;
        int wgid = (int)L; { const int q = nwg / NXCD, r = nwg % NXCD, xcd = wgid % NXCD, off = wgid / NXCD; wgid = (xcd < r ? xcd * (q + 1) : r * (q + 1) + (xcd - r) * q) + off; }
        const int nig = WGM * nN, gid = wgid / nig, fm = gid * WGM, gsz = (nM - fm) < WGM ? (nM - fm) : WGM;
        u.pm = fm + ((wgid % nig) % gsz); u.pn = (wgid % nig) / gsz; return true;
    }
    __device__ __forceinline__ void a_ready(const Unit&) const {}
    __device__ __forceinline__ void done(const Unit&) const {}
};

__device__ __forceinline__ unsigned cvt_pk_bf16(float lo, float hi) { unsigned r; asm volatile("v_cvt_pk_bf16_f32 %0, %1, %2" : "=v"(r) : "v"(lo), "v"(hi)); return r; }
typedef float f32x2 __attribute__((ext_vector_type(2)));
typedef unsigned u32x2 __attribute__((ext_vector_type(2)));
__device__ __forceinline__ float fast_sigmoid(float a) { return __builtin_amdgcn_rcpf(1.0f + __builtin_amdgcn_exp2f(-1.4426950408889634f * a)); }
struct EpiF32 {
    static constexpr bool PERM = false, AFTER_DRAIN = false;
    float* O; int ldc;
    __device__ __forceinline__ void operator()(const f32x4 (&acc)[2][2][4][2], const Unit& u, int wr, int wc, int fr, int fq) const {
        const int row0 = u.pm * BM + wr * 64 + fr, col0 = u.pn * BM + wc * 32 + 4 * fq;
#pragma unroll
        for (int ai = 0; ai < 2; ++ai)
#pragma unroll
            for (int m = 0; m < 4; ++m) { float* rowp = O + (size_t)(row0 + ai * HALF + m * 16) * ldc + col0;
#pragma unroll
                for (int bj = 0; bj < 2; ++bj)
#pragma unroll
                    for (int n = 0; n < 2; ++n) *(f32x4*)(rowp + bj * HALF + n * 16) = acc[ai][bj][m][n]; }
    }
};
struct EpiSwiglu {
    static constexpr bool PERM = true, AFTER_DRAIN = false;
    bf16_t* H; int ldh;
    __device__ __forceinline__ void operator()(const f32x4 (&acc)[2][2][4][2], const Unit& u, int wr, int wc, int fr, int fq) const {
        const int row0 = u.pm * BM + wr * 64 + fr, col0 = u.pn * HALF + wc * 32 + 8 * fq;
#pragma unroll
        for (int ai = 0; ai < 2; ++ai)
#pragma unroll
            for (int m = 0; m < 4; ++m) { bf16_t* rowp = H + (size_t)(row0 + ai * HALF + m * 16) * ldh + col0;
                f32x4 h0, h1;
#pragma unroll
                for (int e = 0; e < 4; ++e) { const float a0 = acc[ai][0][m][0][e], a1 = acc[ai][0][m][1][e];
                    h0[e] = a0 * fast_sigmoid(a0) * acc[ai][1][m][0][e]; h1[e] = a1 * fast_sigmoid(a1) * acc[ai][1][m][1][e]; }
                u32x4 w; w.x = cvt_pk_bf16(h0[0], h0[1]); w.y = cvt_pk_bf16(h0[2], h0[3]); w.z = cvt_pk_bf16(h1[0], h1[1]); w.w = cvt_pk_bf16(h1[2], h1[3]);
                *(u32x4*)rowp = w; }
    }
};
struct EpiInProj {
    static constexpr bool PERM = true, AFTER_DRAIN = false;
    bf16_t *QA, *KA, *VA, *QR, *KR, *VR, *GR; const float *qg, *kg, *cosT, *sinT; float qscale;
    __device__ __forceinline__ void operator()(const f32x4 (&acc)[2][2][4][2], const Unit& u, int wr, int wc, int fr, int fq) const {
        const int g = u.pn * 4 + wc; const bool isctx = u.pm >= 128;
        int kind, gl; bf16_t* base; int pitch = 512;
        if (g < 8) { kind = 0; gl = g; base = QA; } else if (g < 10) { kind = 1; gl = g - 8; base = KA; pitch = 128; } else if (g < 12) { kind = 2; gl = g - 10; base = VA; pitch = 128; }
        else if (g < 20) { kind = 3; gl = g - 12; base = QR; } else if (g < 28) { kind = 4; gl = g - 20; base = KR; } else if (g < 36) { kind = 5; gl = g - 28; base = VR; } else { kind = 6; gl = g - 36; base = GR; }
        const bool donorm = kind <= 1, dorope = !isctx && (kind == 0 || kind == 1 || kind == 3 || kind == 4);
        const float osc = kind == 0 ? qscale : (kind == 4 ? 0.125f : 1.0f);
        const int j0 = 8 * fq;
        const float* gsrc = kind == 0 ? qg : kg;
#pragma unroll
        for (int ai = 0; ai < 2; ++ai)
#pragma unroll
            for (int m = 0; m < 4; ++m) {
                const int row = u.pm * BM + ai * HALF + wr * 64 + m * 16 + fr;
                float rstd = 1.0f;
                if (donorm) {
                    float ss = 0.f;
#pragma unroll
                    for (int bj = 0; bj < 2; ++bj)
#pragma unroll
                        for (int n = 0; n < 2; ++n) { const f32x4 t = acc[ai][bj][m][n]; ss += (t[0] * t[0] + t[1] * t[1]) + (t[2] * t[2] + t[3] * t[3]); }
                    ss += __shfl_xor(ss, 16); ss += __shfl_xor(ss, 32);
                    rstd = 1.0f / sqrtf(ss * (1.0f / 64.0f) + 1e-6f);
                }
                size_t drow;
                if (kind == 1 || kind == 2) { drow = isctx ? (size_t)((row - 32768) >> 8) * 8448 + ((row - 32768) & 255) : (size_t)(row >> 13) * 8448 + 256 + (row & 8191); }
                else drow = (size_t)row;
                bf16_t* dp = base + drow * pitch + gl * 64 + j0;
                const int pos = row & 8191;
#pragma unroll
                for (int n = 0; n < 2; ++n) {
                    f32x4 x1 = acc[ai][0][m][n], x2 = acc[ai][1][m][n];
                    if (donorm) { x1 = x1 * rstd * *(const f32x4*)(gsrc + j0 + 4 * n); x2 = x2 * rstd * *(const f32x4*)(gsrc + 32 + j0 + 4 * n); }
                    if (dorope) { const f32x4 c = *(const f32x4*)(cosT + pos * 32 + j0 + 4 * n), s = *(const f32x4*)(sinT + pos * 32 + j0 + 4 * n);
                        const f32x4 y1 = x1 * c - x2 * s, y2 = x1 * s + x2 * c; x1 = y1; x2 = y2; }
                    x1 = x1 * osc; x2 = x2 * osc;
                    u32x2 w1, w2; w1.x = cvt_pk_bf16(x1[0], x1[1]); w1.y = cvt_pk_bf16(x1[2], x1[3]); w2.x = cvt_pk_bf16(x2[0], x2[1]); w2.y = cvt_pk_bf16(x2[2], x2[3]);
                    *(u32x2*)(dp + 4 * n) = w1; *(u32x2*)(dp + 32 + 4 * n) = w2;
                }
            }
    }
};
template <class Epi, class Sched, bool ALIGN_EPI = false, bool SP2 = false>
__device__ __forceinline__ void gemm_phase(PG8_LAS unsigned char* lds, const Gemm g, const Sched& S, const Epi& E) {
    int tid_ = threadIdx.x; asm volatile("" : "+v"(tid_)); const int tid = tid_, wid = __builtin_amdgcn_readfirstlane(tid >> 6), lane = tid & 63, wr = wid >> 2, wc = wid & 3, fr = lane & 15, fq = lane >> 4;
    const int K = g.K, nt = K / BK;
    unsigned voffA[2], voffB[2];
#pragma unroll
    for (int i = 0; i < 2; ++i) { int R, C; stage_rc(tid * 16 + i * 8192, R, C); const int Rb = Epi::PERM ? ((R & ~31) + perm32(R & 31)) : R;
        voffA[i] = (unsigned)(R * K + C) * 2u; voffB[i] = (unsigned)(Rb * K + C) * 2u; }
    const size_t kstep = (size_t)(BK * 2);
    const size_t hstep = (size_t)HALF * K * 2;
    const size_t tstep = 2 * hstep;
    const unsigned ldsw = (unsigned)wid * 1024u;
    const int aoff = lds_byte(wr * 64 + fr, fq * 8), boff = lds_byte(wc * 32 + fr, fq * 8);
#define PG8_SA(b, h) (((b) * 2 + (h)) * HTB)
#define PG8_SB(b, h) ((4 + (b) * 2 + (h)) * HTB)
#define PG8_STAGE(bufoff, gbase, voff) do { _Pragma("unroll") for (int _i = 0; _i < 2; ++_i) \
        __builtin_amdgcn_global_load_lds((const unsigned*)((const char*)(gbase) + (voff)[_i]), (PG8_LAS unsigned*)(lds + (bufoff) + ldsw + _i * 8192), 16, 0, 0); } while (0)
#define PG8_LDA(dst, b, h) do { _Pragma("unroll") for (int m = 0; m < 4; ++m) _Pragma("unroll") for (int k = 0; k < 2; ++k) dst[m][k] = *(const PG8_LAS bf16x8*)(lds + PG8_SA(b, h) + aoff + m * 2048 + k * 1024); } while (0)
#define PG8_LDB(dst, b, h) do { _Pragma("unroll") for (int n = 0; n < 2; ++n) _Pragma("unroll") for (int k = 0; k < 2; ++k) dst[n][k] = *(const PG8_LAS bf16x8*)(lds + PG8_SB(b, h) + boff + n * 2048 + k * 1024); } while (0)
#define PG8_MMA(ai, bj, At, Bt) do { __builtin_amdgcn_s_setprio(1); _Pragma("unroll") for (int m = 0; m < 4; ++m) _Pragma("unroll") for (int n = 0; n < 2; ++n) _Pragma("unroll") for (int k = 0; k < 2; ++k) \
        acc[ai][bj][m][n] = __builtin_amdgcn_mfma_f32_16x16x32_bf16(Bt[n][k], At[m][k], acc[ai][bj][m][n], 0, 0, 0); __builtin_amdgcn_s_setprio(0); } while (0)
#define PG8_WAIT_V(n) asm volatile("s_waitcnt vmcnt(" #n ")" ::: "memory")
#define PG8_WAIT_L(n) asm volatile("s_waitcnt lgkmcnt(" #n ")" ::: "memory")
#define PG8_BAR __builtin_amdgcn_s_barrier()
#define PG8_SCHED __builtin_amdgcn_sched_barrier(0)
    Unit cur, nxt; int ui = 0;
    if (!S.next(0, cur)) return;
    f32x4 acc[2][2][4][2];
#pragma unroll
    for (int a = 0; a < 2; ++a)
#pragma unroll
        for (int b = 0; b < 2; ++b)
#pragma unroll
            for (int m = 0; m < 4; ++m)
#pragma unroll
                for (int n = 0; n < 2; ++n) acc[a][b][m][n] = (f32x4){0.f, 0.f, 0.f, 0.f};
    bf16x8 At[4][2], B0[2][2], B1[2][2];
    const char* cA = (const char*)g.A + (size_t)cur.pm * tstep; const char* cB = (const char*)g.Bt + (size_t)cur.pn * tstep;
    S.a_ready(cur);
    if constexpr (SP2) {
        PG8_STAGE(PG8_SB(0, 0), cB, voffB); PG8_STAGE(PG8_SB(0, 1), cB + hstep, voffB); PG8_STAGE(PG8_SA(0, 0), cA, voffA); PG8_STAGE(PG8_SA(0, 1), cA + hstep, voffA);
        if (wr == 1) PG8_BAR;
        PG8_WAIT_V(2); PG8_BAR;
        PG8_STAGE(PG8_SB(1, 0), cB + kstep, voffB); PG8_STAGE(PG8_SA(1, 0), cA + kstep, voffA); PG8_STAGE(PG8_SB(1, 1), cB + hstep + kstep, voffB);
        PG8_WAIT_V(6); PG8_BAR;
    } else {
        PG8_STAGE(PG8_SB(0, 0), cB, voffB); PG8_STAGE(PG8_SA(0, 0), cA, voffA); PG8_STAGE(PG8_SB(0, 1), cB + hstep, voffB); PG8_STAGE(PG8_SA(0, 1), cA + hstep, voffA);
        if (wr == 1) PG8_BAR;
        PG8_WAIT_V(4); PG8_BAR;
        PG8_STAGE(PG8_SB(1, 0), cB + kstep, voffB); PG8_STAGE(PG8_SA(1, 0), cA + kstep, voffA); PG8_STAGE(PG8_SB(1, 1), cB + hstep + kstep, voffB);
        PG8_WAIT_V(6); PG8_BAR;
    }
    for (;;) {
        const bool has_next = S.next(ui + 1, nxt);
        const char* nA = has_next ? (const char*)g.A + (size_t)nxt.pm * tstep : cA; const char* nB = has_next ? (const char*)g.Bt + (size_t)nxt.pn * tstep : cB;
        for (int t = 0; t < nt; t += 2) {
            const bool last = (t == nt - 2);
            const char* a1 = cA + (size_t)(t + 1) * kstep;
            const char* a2 = last ? nA : cA + (size_t)(t + 2) * kstep; const char* b2 = last ? nB : cB + (size_t)(t + 2) * kstep;
            const char* a3 = a2 + kstep; const char* b3 = b2 + kstep;
            if (last && has_next) S.a_ready(nxt);
            if constexpr (SP2) {
            PG8_LDB(B0, 0, 0); PG8_LDB(B1, 0, 1); PG8_SCHED; PG8_LDA(At, 0, 0); PG8_STAGE(PG8_SA(1, 1), a1 + hstep, voffA);
            PG8_WAIT_V(8); PG8_WAIT_L(0); PG8_BAR; PG8_MMA(0, 0, At, B0); PG8_MMA(0, 1, At, B1); PG8_BAR; PG8_SCHED;
            PG8_LDA(At, 0, 1); PG8_STAGE(PG8_SB(0, 0), b2, voffB); PG8_STAGE(PG8_SB(0, 1), b2 + hstep, voffB); PG8_STAGE(PG8_SA(0, 0), a2, voffA);
            PG8_WAIT_V(8); PG8_WAIT_L(0); PG8_BAR; PG8_MMA(1, 0, At, B0); PG8_MMA(1, 1, At, B1); PG8_BAR; PG8_SCHED;
            PG8_LDB(B0, 1, 0); PG8_LDB(B1, 1, 1); PG8_SCHED; PG8_LDA(At, 1, 0); PG8_STAGE(PG8_SA(0, 1), a2 + hstep, voffA);
            PG8_WAIT_V(8); PG8_WAIT_L(0); PG8_BAR; PG8_MMA(0, 0, At, B0); PG8_MMA(0, 1, At, B1); PG8_BAR; PG8_SCHED;
            PG8_LDA(At, 1, 1); PG8_STAGE(PG8_SB(1, 0), b3, voffB); PG8_STAGE(PG8_SB(1, 1), b3 + hstep, voffB); PG8_STAGE(PG8_SA(1, 0), a3, voffA);
            PG8_WAIT_V(8); PG8_WAIT_L(0); PG8_BAR; PG8_MMA(1, 0, At, B0); PG8_MMA(1, 1, At, B1); PG8_BAR; PG8_SCHED;
            } else {
            PG8_LDB(B0, 0, 0); PG8_SCHED; PG8_LDA(At, 0, 0); PG8_STAGE(PG8_SA(1, 1), a1 + hstep, voffA);
            PG8_WAIT_L(8); PG8_BAR; PG8_WAIT_L(0); PG8_MMA(0, 0, At, B0); PG8_BAR; PG8_SCHED;
            PG8_LDB(B1, 0, 1); PG8_STAGE(PG8_SB(0, 0), b2, voffB);
            PG8_BAR; PG8_WAIT_L(0); PG8_MMA(0, 1, At, B1); PG8_BAR;
            PG8_LDA(At, 0, 1); PG8_STAGE(PG8_SA(0, 0), a2, voffA);
            PG8_BAR; PG8_WAIT_L(0); PG8_MMA(1, 0, At, B0); PG8_BAR; PG8_SCHED;
            PG8_STAGE(PG8_SB(0, 1), b2 + hstep, voffB);
            PG8_WAIT_V(6); PG8_BAR; PG8_MMA(1, 1, At, B1); PG8_BAR;
            PG8_LDB(B0, 1, 0); PG8_SCHED; PG8_LDA(At, 1, 0); PG8_STAGE(PG8_SA(0, 1), a2 + hstep, voffA);
            PG8_WAIT_L(8); PG8_BAR; PG8_WAIT_L(0); PG8_MMA(0, 0, At, B0); PG8_BAR; PG8_SCHED;
            PG8_LDB(B1, 1, 1); PG8_STAGE(PG8_SB(1, 0), b3, voffB);
            PG8_BAR; PG8_WAIT_L(0); PG8_MMA(0, 1, At, B1); PG8_BAR;
            PG8_LDA(At, 1, 1); PG8_STAGE(PG8_SA(1, 0), a3, voffA);
            PG8_BAR; PG8_WAIT_L(0); PG8_MMA(1, 0, At, B0); PG8_BAR; PG8_SCHED;
            PG8_STAGE(PG8_SB(1, 1), b3 + hstep, voffB);
            PG8_WAIT_V(6); PG8_BAR; PG8_MMA(1, 1, At, B1); PG8_BAR;
            }
        }
        if constexpr (ALIGN_EPI) { if (wr == 0) PG8_BAR; }
        if constexpr (!Epi::AFTER_DRAIN) { E(acc, cur, wr, wc, fr, fq); S.done(cur); }
        if (!has_next) break;
#pragma unroll
        for (int a = 0; a < 2; ++a)
#pragma unroll
            for (int b = 0; b < 2; ++b)
#pragma unroll
                for (int m = 0; m < 4; ++m)
#pragma unroll
                    for (int n = 0; n < 2; ++n) acc[a][b][m][n] = (f32x4){0.f, 0.f, 0.f, 0.f};
        cur = nxt; cA = nA; cB = nB; ++ui;
        if constexpr (ALIGN_EPI) { if (wr == 1) PG8_BAR; }
    }
    PG8_WAIT_V(0);
    if constexpr (!ALIGN_EPI) { if (wr == 0) PG8_BAR; }
    PG8_BAR;
    if constexpr (Epi::AFTER_DRAIN) { E.fused(acc, cur, wr, wc, fr, fq, lds, wid, lane); S.done(cur); }
#undef PG8_SA
#undef PG8_SB
#undef PG8_STAGE
#undef PG8_LDA
#undef PG8_LDB
#undef PG8_MMA
#undef PG8_WAIT_V
#undef PG8_WAIT_L
#undef PG8_BAR
#undef PG8_SCHED
}
}
#include <hip/hip_bf16.h>
#include <cmath>
namespace attn_body {
using bf16=__hip_bfloat16;
using bf16x8=__attribute__((ext_vector_type(8)))short;
using s16x4=__attribute__((ext_vector_type(4)))short;
using f32x16=__attribute__((ext_vector_type(16)))float;
using u32x4=__attribute__((ext_vector_type(4)))unsigned;
constexpr int BATCH=4,NHEAD=8,SEQQ=8192,SEQK=8448,D=64,QP=512,KP=128,OP=1024;
constexpr int NW=8,QBLK=32,QB=QBLK*NW,KVBLK=64,NQB=SEQQ/QB;
constexpr int ATTN_UNIT_ROWS=QB;
__device__ __forceinline__ int crow(int r,int hi){return (r&3)+8*(r>>2)+4*hi;}
#define SBAR() __builtin_amdgcn_sched_barrier(0)
__device__ __forceinline__ void cmask(f32x16&p0,f32x16&p1,int jb,int qrel,int hi){
  const float NEG=-INFINITY; int kb=64*jb+4*hi;
  #pragma unroll
  for(int r=0;r<16;++r){int kv=kb+(r&3)+8*(r>>2); if(kv>qrel)p0[r]=NEG; if(kv+32>qrel)p1[r]=NEG;}
}

constexpr int NSLOT=3, SLOTB=8192;
constexpr int LDS_K=0, LDS_V=NSLOT*SLOTB, LDS_WS=2*NSLOT*SLOTB, LDS_OST=LDS_WS+NW*64*4, LDS_BYTES=LDS_OST+NW*4096;
constexpr float C2=0.125f*1.4426950408889634f;
__device__ __forceinline__ void glds16(const void*gsrc,unsigned lds_dst){unsigned keep;
  asm volatile("s_mov_b32 %0, m0\n\ts_mov_b32 m0, %2\n\ts_nop 0\n\tglobal_load_lds_dwordx4 %1, off\n\ts_mov_b32 m0, %0":"=&s"(keep):"v"(gsrc),"s"(lds_dst):"memory");}
__device__ __forceinline__ float max3f(float a,float b,float c){float r;asm("v_max3_f32 %0, %1, %2, %3":"=v"(r):"v"(a),"v"(b),"v"(c));return r;}
__device__ __forceinline__ float max2f(float a,float b){float r;asm("v_max_f32_e32 %0, %1, %2":"=v"(r):"v"(a),"v"(b));return r;}
__device__ __forceinline__ float fadd_s(float a,float b){float r;asm("v_add_f32_e32 %0, %1, %2":"=v"(r):"v"(a),"v"(b));return r;}
__device__ __forceinline__ float fsub_s(float a,float b){float r;asm("v_sub_f32_e32 %0, %1, %2":"=v"(r):"v"(a),"v"(b));return r;}
typedef float f32x2_t __attribute__((ext_vector_type(2))); typedef __bf16 bf16x2_t __attribute__((ext_vector_type(2)));
__device__ __forceinline__ unsigned cvtpk_s(float lo,float hi){f32x2_t v={lo,hi};bf16x2_t b=__builtin_convertvector(v,bf16x2_t);return __builtin_bit_cast(unsigned,b);}
#define WAIT_BAR(N) asm volatile("s_waitcnt vmcnt(" #N ") lgkmcnt(0)\n\ts_barrier":::"memory")

__device__ __forceinline__ void qkt(f32x16&p0,f32x16&p1,const char*Kslot,const bf16x8*qr,const f32x16&negm,int r32,int hi){
  const char*kb=Kslot+hi*1024+r32*16;
  #pragma unroll
  for(int d0=0;d0<4;++d0){
    const bf16x8 b0=*reinterpret_cast<const bf16x8*>(kb+d0*2048);
    const bf16x8 b1=*reinterpret_cast<const bf16x8*>(kb+d0*2048+512);
    if(d0==0){p0=__builtin_amdgcn_mfma_f32_32x32x16_bf16(b0,qr[0],negm,0,0,0);p1=__builtin_amdgcn_mfma_f32_32x32x16_bf16(b1,qr[0],negm,0,0,0);}
    else{p0=__builtin_amdgcn_mfma_f32_32x32x16_bf16(b0,qr[d0],p0,0,0,0);p1=__builtin_amdgcn_mfma_f32_32x32x16_bf16(b1,qr[d0],p1,0,0,0);}}
}
typedef __attribute__((address_space(3))) const char* lds_cptr;
typedef short v4i16_t __attribute__((ext_vector_type(4)));
__device__ __forceinline__ void kload8(bf16x8*kf,lds_cptr kp){
  kf[0]=*(const __attribute__((address_space(3))) bf16x8*)(kp);      kf[1]=*(const __attribute__((address_space(3))) bf16x8*)(kp+512);
  kf[2]=*(const __attribute__((address_space(3))) bf16x8*)(kp+2048); kf[3]=*(const __attribute__((address_space(3))) bf16x8*)(kp+2560);
  kf[4]=*(const __attribute__((address_space(3))) bf16x8*)(kp+4096); kf[5]=*(const __attribute__((address_space(3))) bf16x8*)(kp+4608);
  kf[6]=*(const __attribute__((address_space(3))) bf16x8*)(kp+6144); kf[7]=*(const __attribute__((address_space(3))) bf16x8*)(kp+6656);
}
__device__ __forceinline__ void kload2(bf16x8*kf,lds_cptr kp,int j){ kf[2*j]=*(const __attribute__((address_space(3))) bf16x8*)(kp+j*2048); kf[2*j+1]=*(const __attribute__((address_space(3))) bf16x8*)(kp+j*2048+512); }
__device__ __forceinline__ s16x4 vtr(lds_cptr p){ return __builtin_bit_cast(s16x4,__builtin_amdgcn_ds_read_tr16_b64_v4i16((__attribute__((address_space(3))) v4i16_t*)p)); }
__device__ __forceinline__ float rowmax(const f32x16&p0,const f32x16&p1){
  float a=max3f(p0[0],p0[1],p1[0]),b=max3f(p0[2],p0[3],p1[1]);a=max3f(a,p1[2],p1[3]);
  #pragma unroll
  for(int r=4;r<16;r+=4){a=max3f(a,p0[r],p0[r+1]);b=max3f(b,p0[r+2],p0[r+3]);a=max3f(a,p1[r],p1[r+1]);b=max3f(b,p1[r+2],p1[r+3]);}
  const float m=max2f(a,b);
  auto rr=__builtin_amdgcn_permlane32_swap(__float_as_uint(m),__float_as_uint(m),false,false);
  return max2f(__uint_as_float(rr[0]),__uint_as_float(rr[1]));
}
__device__ __forceinline__ void pv(f32x16*o,int vb,bf16x8 pa0,bf16x8 pa1,bf16x8 pa2,bf16x8 pa3){
  #pragma unroll
  for(int d0=0;d0<2;++d0){s16x4 lo[4],hi[4];
    #pragma unroll
    for(int ks=0;ks<4;++ks){
      asm volatile("ds_read_b64_tr_b16 %0,%1 offset:%c2":"=&v"(lo[ks]):"v"(vb),"i"(d0*4096+ks*1024):"memory");
      asm volatile("ds_read_b64_tr_b16 %0,%1 offset:%c2":"=&v"(hi[ks]):"v"(vb),"i"(d0*4096+ks*1024+512):"memory");}
    asm volatile("s_waitcnt lgkmcnt(0)":::"memory");SBAR();
    #define PK(k) (bf16x8){lo[k][0],lo[k][1],lo[k][2],lo[k][3],hi[k][0],hi[k][1],hi[k][2],hi[k][3]}
    o[d0]=__builtin_amdgcn_mfma_f32_32x32x16_bf16(pa0,PK(0),o[d0],0,0,0);
    o[d0]=__builtin_amdgcn_mfma_f32_32x32x16_bf16(pa1,PK(1),o[d0],0,0,0);
    o[d0]=__builtin_amdgcn_mfma_f32_32x32x16_bf16(pa2,PK(2),o[d0],0,0,0);
    o[d0]=__builtin_amdgcn_mfma_f32_32x32x16_bf16(pa3,PK(3),o[d0],0,0,0);
    #undef PK
  }
}

#ifndef ATTN_STORE16
#define ATTN_STORE16(p,v) (*(u32x4*)(p)=(v))
#endif
template<int THRL> __device__ __forceinline__ void attn_unit(int b,int h,int qb,const bf16*Q,const bf16*__restrict__ K,const bf16*__restrict__ V,bf16*O,char*shm){
  int tid_=threadIdx.x; asm volatile("":"+v"(tid_)); const int tid=tid_,lane=tid&63,r32=lane&31,hi=lane>>5; const int wid=__builtin_amdgcn_readfirstlane(tid>>6);
  const int q0=qb*QB; const long qrow=(long)b*SEQQ+q0+wid*QBLK; const int kvh=h>>2;
  const bf16*Qw=Q+qrow*QP+h*D;
  const bf16*Kh=K+(long)b*SEQK*KP+kvh*D,*Vh=V+(long)b*SEQK*KP+kvh*D;
  const unsigned lds0=(unsigned)(uintptr_t)shm;
  float*wsf=(float*)(shm+LDS_WS)+wid*64;
  const bf16*ksrc=Kh+(long)lane*KP+wid*8;
  const bf16*vsrc=Vh+(long)(16*(wid&3)+(lane>>2))*KP+(wid>>2)*32+(lane&3)*8;
  const unsigned kdst=lds0+LDS_K+wid*1024, vdst=lds0+LDS_V+wid*1024;
  #define DMA_K(t,slot) glds16(ksrc+(long)(t)*KVBLK*KP,(unsigned)__builtin_amdgcn_readfirstlane(kdst+(slot)))
  #define DMA_V(t,slot) glds16(vsrc+(long)(t)*KVBLK*KP,(unsigned)__builtin_amdgcn_readfirstlane(vdst+(slot)))
  const int vb0=(int)(lds0+LDS_V)+((lane>>4)&1)*32+(lane&3)*8+(4*hi+((lane&15)>>2))*64;
  const char*Kbase=shm+LDS_K; bf16x8 kf[8];
  const lds_cptr shm3=(lds_cptr)shm; const lds_cptr kp0=shm3+LDS_K+hi*1024+r32*16; const lds_cptr vp0=shm3+LDS_V+((lane>>4)&1)*32+(lane&3)*8+(4*hi+((lane&15)>>2))*64;
  constexpr int NT=SEQK/KVBLK;
  DMA_K(0,0);DMA_V(0,0);DMA_K(1,SLOTB);
  bf16x8 qr[4];
  #pragma unroll
  for(int d0=0;d0<4;++d0)qr[d0]=*reinterpret_cast<const bf16x8*>(&Qw[(long)r32*QP+d0*16+hi*8]);
  float mhat=0.f,l_reg=0.f;f32x16 o[2];o[0]=f32x16{};o[1]=f32x16{};f32x16 negm=f32x16{};asm volatile("":"+v"(negm));
  #define CMASK(P0,P1,t) do{}while(0)
  bool resc=false;
  #define START(P0,P1) do{ const float rm=rowmax(P0,P1); resc=false; \
    { const float dl=rm; mhat=fadd_s(mhat,dl); \
      _Pragma("unroll") for(int r=0;r<16;++r){P0[r]=fsub_s(P0[r],dl);P1[r]=fsub_s(P1[r],dl);} \
      _Pragma("unroll") for(int r=0;r<16;++r)negm[r]=-mhat; asm volatile("":"+v"(negm)); } \
    _Pragma("unroll") for(int r=0;r<16;++r)P0[r]=__builtin_amdgcn_exp2f(P0[r]); }while(0)
  #define RESC() do{ if(resc){ asm volatile("s_waitcnt lgkmcnt(0)":::"memory"); \
      _Pragma("unroll") for(int d_=0;d_<2;++d_) _Pragma("unroll") for(int r=0;r<16;++r)o[d_][r]*=wsf[crow(r,hi)]; } }while(0)
  f32x16 pA0,pA1,pB0,pB1;
  int sl_prev=0,sl_cur=0,sl_next=SLOTB;
  #define ROT() do{sl_prev=sl_cur;sl_cur=sl_next;sl_next=(sl_next==(NSLOT-1)*SLOTB)?0:sl_next+SLOTB;}while(0)
  DMA_K(2,2*SLOTB);
  WAIT_BAR(3);
  qkt(pA0,pA1,Kbase,qr,negm,r32,hi);asm volatile("s_nop 15\n\ts_nop 7":"+v"(pA0),"+v"(pA1));CMASK(pA0,pA1,0);
  START(pA0,pA1);
  _Pragma("unroll") for(int r=0;r<16;++r)pA1[r]=__builtin_amdgcn_exp2f(pA1[r]);
  WAIT_BAR(0);
  DMA_K(3,0);DMA_V(1,SLOTB);
  ROT();
  kload8(kf,kp0+sl_cur);
  WAIT_BAR(2);
  s16x4 vlo[8],vhi[8]; u32x4 pw0,pw1,pw2,pw3;
  #define PKW(P,B) cvtpk_s(P[B],P[B+1])
  #define PAF(k) __builtin_bit_cast(bf16x8,pw##k)
  #define VFR(i) (bf16x8){vlo[i][0],vlo[i][1],vlo[i][2],vlo[i][3],vhi[i][0],vhi[i][1],vhi[i][2],vhi[i][3]}
  #define PIN(x) asm volatile("":"+v"(x))
  #define MX3(a,b,c) __builtin_fmaxf(__builtin_fmaxf((a),(b)),(c))
  #define GAPA(MF,A0,A1,A2,A3,W0,W1,PW) do{ MF; sacc+=A0; sacc+=A1; sacc+=A2; sacc+=A3; PIN(sacc); W0; W1; PIN(PW); SBAR(); }while(0)
  #define EX(v) __builtin_amdgcn_exp2f(v)
  #define GAPB(MF,X,B) do{ MF; X[B]=EX(X[B]); X[B+1]=EX(X[B+1]); X[B+2]=EX(X[B+2]); X[B+3]=EX(X[B+3]); PIN(X); SBAR(); }while(0)
  #define VRD(i) do{ vlo[i]=vtr(vp_+(((i)>>2)*4096+((i)&3)*1024)); vhi[i]=vtr(vp_+(((i)>>2)*4096+((i)&3)*1024+512)); }while(0)
  #define KRD(G,j) do{ if(G){ kload2(kf,kp0+sl_next,j); SBAR(); } }while(0)
  #define STEP(C0,C1,P0,P1,t,GK,GV,GL) do{ SBAR(); \
    const lds_cptr vp_=vp0+sl_prev; \
    VRD(0); SBAR(); float sacc=(P0[0]+P0[1]); \
    GAPA(C0=__builtin_amdgcn_mfma_f32_32x32x16_bf16(kf[0],qr[0],negm,0,0,0), P0[2],P0[3],P0[4],P0[5],     pw0[0]=PKW(P0,0), pw0[1]=PKW(P0,2), pw0); \
    VRD(4); SBAR(); GAPA(C1=__builtin_amdgcn_mfma_f32_32x32x16_bf16(kf[1],qr[0],negm,0,0,0), P0[6],P0[7],P0[8],P0[9],     pw0[2]=PKW(P0,4), pw0[3]=PKW(P0,6), pw0); \
    VRD(1); SBAR(); GAPA(C0=__builtin_amdgcn_mfma_f32_32x32x16_bf16(kf[2],qr[1],C0,0,0,0),   P0[10],P0[11],P0[12],P0[13], pw1[0]=PKW(P0,8), pw1[1]=PKW(P0,10), pw1); \
    VRD(5); SBAR(); GAPA(C1=__builtin_amdgcn_mfma_f32_32x32x16_bf16(kf[3],qr[1],C1,0,0,0),   P0[14],P0[15],P1[0],P1[1],   pw1[2]=PKW(P0,12),pw1[3]=PKW(P0,14), pw1); \
    VRD(2); SBAR(); GAPA(C0=__builtin_amdgcn_mfma_f32_32x32x16_bf16(kf[4],qr[2],C0,0,0,0),   P1[2],P1[3],P1[4],P1[5],     pw2[0]=PKW(P1,0), pw2[1]=PKW(P1,2), pw2); \
    VRD(6); SBAR(); GAPA(C1=__builtin_amdgcn_mfma_f32_32x32x16_bf16(kf[5],qr[2],C1,0,0,0),   P1[6],P1[7],P1[8],P1[9],     pw2[2]=PKW(P1,4), pw2[3]=PKW(P1,6), pw2); \
    VRD(3); SBAR(); GAPA(C0=__builtin_amdgcn_mfma_f32_32x32x16_bf16(kf[6],qr[3],C0,0,0,0),   P1[10],P1[11],P1[12],P1[13], pw3[0]=PKW(P1,8), pw3[1]=PKW(P1,10), pw3); \
    VRD(7); SBAR(); GAPA(C1=__builtin_amdgcn_mfma_f32_32x32x16_bf16(kf[7],qr[3],C1,0,0,0),   P1[14],P1[15],0.f,0.f,       pw3[2]=PKW(P1,12),pw3[3]=PKW(P1,14), pw3); \
    l_reg+=sacc; \
    if(GK){DMA_K((t)+3,sl_cur);} if(GV){DMA_V((t)+1,sl_next);} \
    CMASK(C0,C1,t); \
    { float a=MX3(C0[0],C0[1],C1[0]),b=MX3(C0[2],C0[3],C1[1]); a=MX3(a,C1[2],C1[3]); \
      _Pragma("unroll") for(int r=4;r<16;r+=4){a=MX3(a,C0[r],C0[r+1]);b=MX3(b,C0[r+2],C0[r+3]);a=MX3(a,C1[r],C1[r+1]);b=MX3(b,C1[r+2],C1[r+3]);} \
      float rm=__builtin_fmaxf(a,b); { auto rr=__builtin_amdgcn_permlane32_swap(__float_as_uint(rm),__float_as_uint(rm),false,false); rm=__builtin_fmaxf(__uint_as_float(rr[0]),__uint_as_float(rr[1])); } \
      resc=false; \
      if(__builtin_expect(__any(rm>(float)THRL),0)){ const float dl=__builtin_fmaxf(rm,0.f); mhat+=dl; \
        _Pragma("unroll") for(int r=0;r<16;++r){C0[r]-=dl;C1[r]-=dl;} \
        _Pragma("unroll") for(int r=0;r<16;++r)negm[r]=-mhat; asm volatile("":"+v"(negm)); \
        const float f=__builtin_amdgcn_exp2f(-dl); l_reg*=f; if(hi==0)wsf[r32]=f; resc=true; } } \
    SBAR(); \
    GAPB(o[0]=__builtin_amdgcn_mfma_f32_32x32x16_bf16(PAF(0),VFR(0),o[0],0,0,0), C0,0); \
    GAPB(o[1]=__builtin_amdgcn_mfma_f32_32x32x16_bf16(PAF(0),VFR(4),o[1],0,0,0), C0,4); \
    KRD(GL,0); GAPB(o[0]=__builtin_amdgcn_mfma_f32_32x32x16_bf16(PAF(1),VFR(1),o[0],0,0,0), C0,8); \
    KRD(GL,1); GAPB(o[1]=__builtin_amdgcn_mfma_f32_32x32x16_bf16(PAF(1),VFR(5),o[1],0,0,0), C0,12); \
    KRD(GL,2); GAPB(o[0]=__builtin_amdgcn_mfma_f32_32x32x16_bf16(PAF(2),VFR(2),o[0],0,0,0), C1,0); \
    KRD(GL,3); GAPB(o[1]=__builtin_amdgcn_mfma_f32_32x32x16_bf16(PAF(2),VFR(6),o[1],0,0,0), C1,4); \
    GAPB(o[0]=__builtin_amdgcn_mfma_f32_32x32x16_bf16(PAF(3),VFR(3),o[0],0,0,0), C1,8); \
    GAPB(o[1]=__builtin_amdgcn_mfma_f32_32x32x16_bf16(PAF(3),VFR(7),o[1],0,0,0), C1,12); \
    }while(0)
  int t=1;
  #undef CMASK
  #define CMASK(P0,P1,t) do{}while(0)
  for(;t+5<NT;t+=2){
    STEP(pB0,pB1,pA0,pA1,t,true,true,true);     WAIT_BAR(2); RESC(); ROT();
    STEP(pA0,pA1,pB0,pB1,t+1,true,true,true);   WAIT_BAR(2); RESC(); ROT();
  }
  #undef CMASK
  #define CMASK(P0,P1,t) do{}while(0)
  #define ENDW(tt) do{ if((tt)+3<NT){WAIT_BAR(2);} else if((tt)+2<NT){WAIT_BAR(1);} else {WAIT_BAR(0);} }while(0)
  for(;t+1<NT;t+=2){
    STEP(pB0,pB1,pA0,pA1,t,(t+3<NT),(t+1<NT),(t+1<NT));       ENDW(t);   RESC(); ROT();
    STEP(pA0,pA1,pB0,pB1,t+1,(t+4<NT),(t+2<NT),(t+2<NT));     ENDW(t+1); RESC(); ROT();
  }
  STEP(pB0,pB1,pA0,pA1,NT-1,false,false,false); RESC();
  { float sacc=pB0[0]+pB0[1]; _Pragma("unroll") for(int r=2;r<16;++r)sacc+=pB0[r]; _Pragma("unroll") for(int r=0;r<16;++r)sacc+=pB1[r]; l_reg+=sacc;
    pw0=(u32x4){PKW(pB0,0),PKW(pB0,2),PKW(pB0,4),PKW(pB0,6)};pw1=(u32x4){PKW(pB0,8),PKW(pB0,10),PKW(pB0,12),PKW(pB0,14)};pw2=(u32x4){PKW(pB1,0),PKW(pB1,2),PKW(pB1,4),PKW(pB1,6)};pw3=(u32x4){PKW(pB1,8),PKW(pB1,10),PKW(pB1,12),PKW(pB1,14)};
    SBAR(); pv(o,vb0+sl_cur,PAF(0),PAF(1),PAF(2),PAF(3)); }
  #undef PKW
  #undef PAF
  #undef VFR
  #undef PIN
  #undef MX3
  #undef GAPA
  #undef GAPB
  #undef EX
  #undef VRD
  #undef KRD
  #undef STEP
  #undef ENDW
  {auto rr=__builtin_amdgcn_permlane32_swap(__float_as_uint(l_reg),__float_as_uint(l_reg),false,false);l_reg=__uint_as_float(rr[0])+__uint_as_float(rr[1]);}
  if(hi==0)wsf[32+r32]=l_reg;asm volatile("s_waitcnt lgkmcnt(0)":::"memory");
  float rli[16];
  #pragma unroll
  for(int r=0;r<16;++r)rli[r]=__builtin_amdgcn_rcpf(wsf[32+crow(r,hi)]);
  bf16*Ow=O+qrow*OP+h*D;
  { bf16*stg=(bf16*)(shm+LDS_OST)+wid*2048;
    #pragma unroll
    for(int r=0;r<16;++r){const int orow=crow(r,hi);
      #pragma unroll
      for(int d0=0;d0<2;++d0)stg[orow*64+d0*32+r32]=__float2bfloat16(o[d0][r]*rli[r]);}
    asm volatile("s_waitcnt lgkmcnt(0)":::"memory");
    #pragma unroll
    for(int i=0;i<4;++i){const int row=i*8+(lane>>3),ch=lane&7; const u32x4 v=*(const u32x4*)(stg+row*64+ch*8); ATTN_STORE16(Ow+(long)row*OP+ch*8,v);} }
  asm volatile("s_waitcnt lgkmcnt(0)\n\ts_barrier":::"memory");
  #undef DMA_K
  #undef DMA_V
  #undef CMASK
  #undef START
  #undef RESC
  #undef ROT
}
constexpr int ATTN_LDS_BYTES=LDS_BYTES;
struct AttnTensors { const bf16* Q; const bf16* K; const bf16* V; bf16* O; };
struct AttnUnit { int bh; int qb; };
struct StaticOrder {
  int vcu;
  __device__ __forceinline__ explicit StaticOrder(int grid,int block):vcu((grid%8==0)?(block%8)*(grid/8)+block/8:block),G(grid){}
  int G;
  __device__ __forceinline__ bool next(int i,AttnUnit&u)const{ const int id=i*G+vcu; if(id>=BATCH*NHEAD*NQB)return false; u.bh=(id&255)>>3; u.qb=(id&7)+8*(id>>8); return true; }
  __device__ __forceinline__ void a_ready(const AttnUnit&)const{}
  __device__ __forceinline__ void done(const AttnUnit&)const{}
};
template<class Sched,int THRL=8> __device__ __forceinline__ void attn_phase(char*lds,const AttnTensors&T,const Sched&S){
  AttnUnit u;
  for(int i=0;S.next(i,u);++i){ S.a_ready(u); attn_unit<THRL>(u.bh/NHEAD,u.bh%NHEAD,u.qb,T.Q,T.K,T.V,T.O,lds); S.done(u); }
}
#undef SBAR
#undef WAIT_BAR
}
constexpr int NWAVES = 8;
constexpr int BATCH = 4, SEQ = 8192, D = 1024, CTXL = 256, NIN = 2816, FFH = 2816;
constexpr int ML = BATCH * SEQ;
constexpr int MC = BATCH * CTXL;
constexpr int MA = ML + MC;
constexpr int NCH = SEQ / 128, NCHA = NCH + 2;
constexpr float EPS = 1e-6f;
constexpr size_t MiB = 1u << 20;
constexpr size_t WS_WIN = 2 * MiB, WS_WOUT = 8 * MiB, WS_WF1 = 10 * MiB, WS_WF2 = 21 * MiB;
constexpr size_t WS_MOD = 27 * MiB;
constexpr size_t WS_COS = 28 * MiB, WS_SIN = 29 * MiB;
constexpr size_t WS_XN = 32 * MiB;
constexpr size_t WS_QA = 98 * MiB;
constexpr size_t WS_KA = 131 * MiB, WS_VA = 140 * MiB;
constexpr size_t WS_QR = 149 * MiB, WS_KR = 182 * MiB, WS_VR = 215 * MiB, WS_GR = 248 * MiB;
constexpr size_t WS_MIXIN = 281 * MiB;
constexpr size_t WS_L = 345 * MiB;
constexpr size_t WS_S = 411 * MiB;
constexpr size_t WS_MIXRAW = 98 * MiB;
constexpr size_t WS_HID = 98 * MiB;
constexpr size_t WS_FFNRAW = 281 * MiB;
constexpr size_t WS_END = 443 * MiB;
static_assert(WS_S + (size_t)32 * 64 * 2 * 4096 * 2 <= WS_END && WS_L + (size_t)32 * 66 * 2 * 4096 * 4 <= WS_S && WS_HID + (size_t)ML * FFH * 2 <= WS_FFNRAW && WS_FFNRAW + (size_t)ML * D * 4 <= WS_END, "d_ws map");
constexpr int RING_BYTES = 131072;
constexpr int LDS_BYTES = 147456;

#define GAS __attribute__((address_space(1)))
#define LAS __attribute__((address_space(3)))
typedef unsigned short bf16;
typedef unsigned v4u __attribute__((ext_vector_type(4)));
typedef unsigned v2u __attribute__((ext_vector_type(2)));
typedef float f32x4 __attribute__((ext_vector_type(4)));
typedef short bf16x8 __attribute__((ext_vector_type(8)));
typedef short bf16x4 __attribute__((ext_vector_type(4)));
#define LDS_WAIT() asm volatile("s_waitcnt lgkmcnt(0)" ::: "memory")
__device__ __forceinline__ unsigned f2bf(float f) { unsigned u = __builtin_bit_cast(unsigned, f); return (u + 0x7fffu + ((u >> 16) & 1u)) >> 16; }
__device__ __forceinline__ unsigned pk2(float lo, float hi) { return f2bf(lo) | (f2bf(hi) << 16); }
__device__ __forceinline__ float bf2f(unsigned short b) { return __builtin_bit_cast(float, (unsigned)b << 16); }
__device__ __forceinline__ float wave_sum(float v) {
#pragma unroll
    for (int o = 1; o < 64; o <<= 1) v += __shfl_xor(v, o);
    return v;
}
__device__ __forceinline__ int fresh_tid() { int t = threadIdx.x; asm volatile("" : "+v"(t)); return t; }
#define PHASE_IDS() const int tid = fresh_tid(), lane = tid & 63, wave = __builtin_amdgcn_readfirstlane(tid >> 6); (void)lane; (void)wave
struct Frame {
    LAS unsigned char* lds;
    int vcu, G;
    const float *x, *c, *ctx, *c_ctx, *w_mod, *b_mod, *g_pre_mix, *g_post_mix, *g_pre_ffn, *g_post_ffn, *w_in, *q_norm_g, *k_norm_g, *dec_f, *dec_b, *w_out, *w_f1, *w_f2;
    float* out; unsigned char* ws;
};
template <int MAP> __device__ __forceinline__ int wrow_map(int n) {
    if (MAP == 1) { const int t = n >> 8, l = n & 255; return (t << 8) + (((l >> 5) & 1) << 7) + ((l >> 6) << 5) + (l & 31); }
    if (MAP == 2) { const int half = n >= FFH ? 1 : 0, rem = n - half * FFH; return ((rem >> 7) << 8) + (half << 7) + (rem & 127); }
    return n;
}
template <int MAP> __device__ __forceinline__ void p0_transpose_item(const float* W, int K, int N, bf16* WT, LAS float* scr, int item, int lane) {
    const int nblk = N / 32, kb = item / nblk, nb = item % nblk, k0 = 64 * kb, n0 = 32 * nb;
#pragma unroll 8
    for (int i = 0; i < 32; ++i) { const int kk = 2 * i + (lane >> 5); scr[kk * 33 + (lane & 31)] = W[(size_t)(k0 + kk) * N + n0 + (lane & 31)]; }
    LDS_WAIT(); asm volatile("" ::: "memory");
    const int c = lane & 7;
#pragma unroll
    for (int j = 0; j < 4; ++j) { const int n = (lane >> 3) + 8 * j; const LAS float* s = scr + (8 * c) * 33 + n;
        v4u o; o.x = pk2(s[0 * 33], s[1 * 33]); o.y = pk2(s[2 * 33], s[3 * 33]); o.z = pk2(s[4 * 33], s[5 * 33]); o.w = pk2(s[6 * 33], s[7 * 33]);
        *(GAS v4u*)(WT + (size_t)wrow_map<MAP>(n0 + n) * K + k0 + 8 * c) = o; }
    LDS_WAIT(); asm volatile("" ::: "memory");
}
__device__ __forceinline__ float silu_f(float a) { return a / (1.0f + __expf(-a)); }
__device__ __forceinline__ void p0_prologue(Frame& F) {
    PHASE_IDS();
    LAS float* scr = (LAS float*)(F.lds + wave * 16384);
    const int gw = F.vcu * NWAVES + wave, NGW = F.G * NWAVES;
    constexpr int I_IN = (D / 64) * (NIN / 32), I_O = (D / 64) * (D / 32), I_1 = (D / 64) * (2 * FFH / 32), I_2 = (FFH / 64) * (D / 32), I_MOD = 96 * 16;
    constexpr int NITEMS = I_IN + I_O + I_1 + I_2 + I_MOD;
    for (int it = gw; it < NITEMS; it += NGW) {
        int r = it;
        if (r < I_MOD) {
            const int cb = r % 96, kc = r / 96, n = cb * 64 + lane, k0 = kc * 64;
            float a0 = 0.f, a1 = 0.f, a2 = 0.f, a3 = 0.f, a4 = 0.f;
            float sv[5];
#pragma unroll
            for (int q = 0; q < 5; ++q) { const float cv = q < 4 ? F.c[q * D + k0 + lane] : F.c_ctx[k0 + lane]; sv[q] = silu_f(cv); }
#pragma unroll 8
            for (int k = 0; k < 64; ++k) { const float w = F.w_mod[(size_t)(k0 + k) * 6144 + n];
                a0 += __shfl(sv[0], k) * w; a1 += __shfl(sv[1], k) * w; a2 += __shfl(sv[2], k) * w; a3 += __shfl(sv[3], k) * w; a4 += __shfl(sv[4], k) * w; }
            if (kc == 0) { const float bb = F.b_mod[n]; a0 += bb; a1 += bb; a2 += bb; a3 += bb; a4 += bb; }
            float* mod = (float*)(F.ws + WS_MOD);
            atomicAdd(mod + 0 * 6144 + n, a0); atomicAdd(mod + 1 * 6144 + n, a1); atomicAdd(mod + 2 * 6144 + n, a2); atomicAdd(mod + 3 * 6144 + n, a3); atomicAdd(mod + 4 * 6144 + n, a4);
            continue;
        } r -= I_MOD;
        if (r < I_IN) { p0_transpose_item<1>(F.w_in, D, NIN, (bf16*)(F.ws + WS_WIN), scr, r, lane); continue; } r -= I_IN;
        if (r < I_O) { p0_transpose_item<0>(F.w_out, D, D, (bf16*)(F.ws + WS_WOUT), scr, r, lane); continue; } r -= I_O;
        if (r < I_1) { p0_transpose_item<2>(F.w_f1, D, 2 * FFH, (bf16*)(F.ws + WS_WF1), scr, r, lane); continue; } r -= I_1;
        p0_transpose_item<0>(F.w_f2, FFH, D, (bf16*)(F.ws + WS_WF2), scr, r, lane);
    }
    float* cosT = (float*)(F.ws + WS_COS); float* sinT = (float*)(F.ws + WS_SIN);
    for (int e = (F.vcu * NWAVES * 64) + tid; e < SEQ * 32; e += F.G * NWAVES * 64) {
        const int pos = e >> 5, j = e & 31; const float p = (float)(j < 16 ? (pos >> 6) : (pos & 63));
        const float inv = powf(10000.0f, -(float)(j & 15) / 16.0f);
        const float ang = p * inv; cosT[e] = cosf(ang); sinT[e] = sinf(ang);
    }
}
__device__ __forceinline__ void p0b_rows(Frame& F) {
    PHASE_IDS();
    const int gw = F.vcu * NWAVES + wave, NGW = F.G * NWAVES;
    const float* mod = (const float*)(F.ws + WS_MOD); bf16* XN = (bf16*)(F.ws + WS_XN);
    for (int m = gw; m < MA; m += NGW) {
        const float* src = m < ML ? F.x + (size_t)m * D : F.ctx + (size_t)(m - ML) * D; const int mr = m < ML ? (m >> 13) : 4;
        const GAS f32x4* xr = (const GAS f32x4*)src + lane;
        f32x4 v[4]; float s = 0.f;
#pragma unroll
        for (int j = 0; j < 4; ++j) { v[j] = xr[64 * j]; s += (v[j].x * v[j].x + v[j].y * v[j].y) + (v[j].z * v[j].z + v[j].w * v[j].w); }
        const float rstd = 1.0f / sqrtf(wave_sum(s) * (1.f / D) + EPS);
        GAS v2u* o8 = (GAS v2u*)(XN + (size_t)m * D) + lane;
#pragma unroll
        for (int j = 0; j < 4; ++j) { const int col = 4 * lane + 256 * j;
            const f32x4 g = *(const f32x4*)(F.g_pre_mix + col), sh = *(const f32x4*)(mod + mr * 6144 + col), sc = *(const f32x4*)(mod + mr * 6144 + 1024 + col);
            const f32x4 y = (v[j] * rstd * g) * (sc + 1.0f) + sh;
            v2u w; w.x = pk2(y.x, y.y); w.y = pk2(y.z, y.w); o8[64 * j] = w; }
    }
}
__device__ __forceinline__ void p5_rows(Frame& F) {
    PHASE_IDS();
    const int gw = F.vcu * NWAVES + wave, NGW = F.G * NWAVES;
    const float* mod = (const float*)(F.ws + WS_MOD); bf16* HF = (bf16*)(F.ws + WS_XN); const float* MIX = (const float*)(F.ws + WS_MIXRAW);
    for (int m = gw; m < ML; m += NGW) {
        const int mr = m >> 13;
        const GAS f32x4* mrw = (const GAS f32x4*)(MIX + (size_t)m * D) + lane; const GAS f32x4* xr = (const GAS f32x4*)(F.x + (size_t)m * D) + lane;
        f32x4 v[4], xv[4]; float s = 0.f;
#pragma unroll
        for (int j = 0; j < 4; ++j) { v[j] = mrw[64 * j]; xv[j] = xr[64 * j]; s += (v[j].x * v[j].x + v[j].y * v[j].y) + (v[j].z * v[j].z + v[j].w * v[j].w); }
        const float rstd = 1.0f / sqrtf(wave_sum(s) * (1.f / D) + EPS);
        float s2 = 0.f;
        GAS f32x4* orow = (GAS f32x4*)(F.out + (size_t)m * D) + lane;
#pragma unroll
        for (int j = 0; j < 4; ++j) { const int col = 4 * lane + 256 * j;
            const f32x4 g = *(const f32x4*)(F.g_post_mix + col), gt = *(const f32x4*)(mod + mr * 6144 + 2048 + col);
            xv[j] = xv[j] + gt * (v[j] * rstd * g); orow[64 * j] = xv[j];
            s2 += (xv[j].x * xv[j].x + xv[j].y * xv[j].y) + (xv[j].z * xv[j].z + xv[j].w * xv[j].w); }
        const float rstd2 = 1.0f / sqrtf(wave_sum(s2) * (1.f / D) + EPS);
        GAS v2u* o8 = (GAS v2u*)(HF + (size_t)m * D) + lane;
#pragma unroll
        for (int j = 0; j < 4; ++j) { const int col = 4 * lane + 256 * j;
            const f32x4 g = *(const f32x4*)(F.g_pre_ffn + col), sh = *(const f32x4*)(mod + mr * 6144 + 3072 + col), sc = *(const f32x4*)(mod + mr * 6144 + 4096 + col);
            const f32x4 y = (xv[j] * rstd2 * g) * (sc + 1.0f) + sh;
            v2u w; w.x = pk2(y.x, y.y); w.y = pk2(y.z, y.w); o8[64 * j] = w; }
    }
}
__device__ __forceinline__ void p8_rows(Frame& F) {
    PHASE_IDS();
    const int gw = F.vcu * NWAVES + wave, NGW = F.G * NWAVES;
    const float* mod = (const float*)(F.ws + WS_MOD); const float* FFN = (const float*)(F.ws + WS_FFNRAW);
    for (int m = gw; m < ML; m += NGW) {
        const int mr = m >> 13;
        const GAS f32x4* fr = (const GAS f32x4*)(FFN + (size_t)m * D) + lane; GAS f32x4* orow = (GAS f32x4*)(F.out + (size_t)m * D) + lane;
        f32x4 v[4], xv[4]; float s = 0.f;
#pragma unroll
        for (int j = 0; j < 4; ++j) { v[j] = fr[64 * j]; xv[j] = orow[64 * j]; s += (v[j].x * v[j].x + v[j].y * v[j].y) + (v[j].z * v[j].z + v[j].w * v[j].w); }
        const float rstd = 1.0f / sqrtf(wave_sum(s) * (1.f / D) + EPS);
#pragma unroll
        for (int j = 0; j < 4; ++j) { const int col = 4 * lane + 256 * j;
            const f32x4 g = *(const f32x4*)(F.g_post_ffn + col), gt = *(const f32x4*)(mod + mr * 6144 + 5120 + col);
            orow[64 * j] = xv[j] + gt * (v[j] * rstd * g); }
    }
}
__device__ __forceinline__ float ret_lg2(const float* dec, int h) { return -1.4426950408889634f * __expf(dec[h]); }
constexpr int RT_STR = 136;
constexpr int RK_STR = 72;
__device__ __forceinline__ int ret_chunk_row(int b, int cc) { return cc < NCH ? b * SEQ + cc * 128 : ML + b * CTXL + (cc - NCH) * 128; }
__device__ __forceinline__ void ret_local_states(Frame& F) {
    PHASE_IDS();
    LAS bf16* Ktf = (LAS bf16*)F.lds; LAS bf16* Ktb = Ktf + 64 * RT_STR; LAS bf16* Vt = Ktb + 64 * RT_STR;
    const bf16* KR = (const bf16*)(F.ws + WS_KR); const bf16* VR = (const bf16*)(F.ws + WS_VR); float* Lb = (float*)(F.ws + WS_L);
    const int j = tid & 127, dq = (tid >> 7) * 16, l15 = lane & 15, quad = lane >> 4;
    for (int un = F.vcu; un < 32 * NCHA; un += F.G) {
        const int bh = un / NCHA, cc = un % NCHA, b = bh >> 3, h = bh & 7;
        const float lf2 = ret_lg2(F.dec_f, h), lb2 = ret_lg2(F.dec_b, h);
        const size_t grow = (size_t)(ret_chunk_row(b, cc) + j) * 512 + h * 64 + dq;
        const v4u k0 = *(const GAS v4u*)(KR + grow), k1 = *(const GAS v4u*)(KR + grow + 8), v0 = *(const GAS v4u*)(VR + grow), v1 = *(const GAS v4u*)(VR + grow + 8);
        const float df = __builtin_amdgcn_exp2f(lf2 * (float)(127 - j)), db = __builtin_amdgcn_exp2f(lb2 * (float)j);
        const unsigned kw[8] = {k0.x, k0.y, k0.z, k0.w, k1.x, k1.y, k1.z, k1.w}, vw[8] = {v0.x, v0.y, v0.z, v0.w, v1.x, v1.y, v1.z, v1.w};
#pragma unroll
        for (int e = 0; e < 8; ++e) {
            const float klo = __builtin_bit_cast(float, kw[e] << 16), khi = __builtin_bit_cast(float, kw[e] & 0xffff0000u);
            Ktf[(dq + 2 * e) * RT_STR + j] = (bf16)f2bf(klo * df); Ktf[(dq + 2 * e + 1) * RT_STR + j] = (bf16)f2bf(khi * df);
            Ktb[(dq + 2 * e) * RT_STR + j] = (bf16)f2bf(klo * db); Ktb[(dq + 2 * e + 1) * RT_STR + j] = (bf16)f2bf(khi * db);
            Vt[(dq + 2 * e) * RT_STR + j] = (bf16)(vw[e] & 0xffffu); Vt[(dq + 2 * e + 1) * RT_STR + j] = (bf16)(vw[e] >> 16);
        }
        __syncthreads();
        {
            const int dir = wave >> 2, et = wave & 3; LAS bf16* Kt = dir ? Ktb : Ktf;
            bf16x8 af[4];
#pragma unroll
            for (int ks = 0; ks < 4; ++ks) af[ks] = *(const LAS bf16x8*)(Vt + (16 * et + l15) * RT_STR + 32 * ks + quad * 8);
            float* dst = Lb + ((size_t)un * 2 + dir) * 4096;
#pragma unroll
            for (int dt = 0; dt < 4; ++dt) { f32x4 acc = {0.f, 0.f, 0.f, 0.f};
#pragma unroll
                for (int ks = 0; ks < 4; ++ks) { const bf16x8 bfr = *(const LAS bf16x8*)(Kt + (16 * dt + l15) * RT_STR + 32 * ks + quad * 8);
                    acc = __builtin_amdgcn_mfma_f32_16x16x32_bf16(af[ks], bfr, acc, 0, 0, 0); }
#pragma unroll
                for (int r = 0; r < 4; ++r) dst[(16 * et + quad * 4 + r) * 64 + 16 * dt + l15] = acc[r]; }
        }
        __syncthreads();
    }
}
__device__ __forceinline__ void ret_scan(Frame& F) {
    PHASE_IDS();
    const float* Lb = (const float*)(F.ws + WS_L); bf16* Sb = (bf16*)(F.ws + WS_S);
    for (int gid = F.vcu * NWAVES * 64 + tid; gid < 32 * 2 * 4096; gid += F.G * NWAVES * 64) {
        const int idx = gid & 4095, dir = (gid >> 12) & 1, bh = gid >> 13, h = bh & 7;
        const float G = __builtin_amdgcn_exp2f(128.0f * ret_lg2(dir ? F.dec_b : F.dec_f, h));
        const float* L = Lb + (size_t)bh * NCHA * 2 * 4096 + dir * 4096 + idx;
        bf16* S = Sb + (size_t)bh * NCH * 2 * 4096 + dir * 4096 + idx;
        float s;
        if (dir == 0) { s = L[(size_t)64 * 8192]; s = s * G + L[(size_t)65 * 8192];
#pragma unroll 8
            for (int c = 0; c < NCH; ++c) { S[(size_t)c * 8192] = (bf16)f2bf(s); s = s * G + L[(size_t)c * 8192]; } }
        else { s = L[(size_t)65 * 8192]; s = s * G + L[(size_t)64 * 8192];
#pragma unroll 8
            for (int c = NCH - 1; c >= 0; --c) { S[(size_t)c * 8192] = (bf16)f2bf(s); s = s * G + L[(size_t)c * 8192]; } }
    }
}
__device__ __forceinline__ void ret_outputs(Frame& F) {
    PHASE_IDS();
    LAS bf16* Kn = (LAS bf16*)F.lds; LAS bf16* Vt = Kn + 128 * RK_STR; LAS bf16* St = Vt + 64 * RT_STR;
    const bf16* QR = (const bf16*)(F.ws + WS_QR); const bf16* KR = (const bf16*)(F.ws + WS_KR); const bf16* VR = (const bf16*)(F.ws + WS_VR); const bf16* GR = (const bf16*)(F.ws + WS_GR);
    const bf16* Sb = (const bf16*)(F.ws + WS_S); bf16* MIX = (bf16*)(F.ws + WS_MIXIN);
    const int l15 = lane & 15, quad = lane >> 4, w = wave;
    for (int un = F.vcu; un < 32 * NCH; un += F.G) {
        const int bh = un / NCH, c = un % NCH, b = bh >> 3, h = bh & 7; const int R0 = b * SEQ + c * 128;
        const float lf2 = ret_lg2(F.dec_f, h), lb2 = ret_lg2(F.dec_b, h);
        { const int j = tid >> 2, part = (tid & 3) * 16; const size_t grow = (size_t)(R0 + j) * 512 + h * 64 + part;
          const v4u k0 = *(const GAS v4u*)(KR + grow), k1 = *(const GAS v4u*)(KR + grow + 8);
          *(LAS v4u*)(Kn + j * RK_STR + part) = k0; *(LAS v4u*)(Kn + j * RK_STR + part + 8) = k1; }
        { const int j = tid & 127, dq = (tid >> 7) * 16; const size_t grow = (size_t)(R0 + j) * 512 + h * 64 + dq;
          const v4u v0 = *(const GAS v4u*)(VR + grow), v1 = *(const GAS v4u*)(VR + grow + 8);
          const unsigned vw[8] = {v0.x, v0.y, v0.z, v0.w, v1.x, v1.y, v1.z, v1.w};
#pragma unroll
          for (int e = 0; e < 8; ++e) { Vt[(dq + 2 * e) * RT_STR + j] = (bf16)(vw[e] & 0xffffu); Vt[(dq + 2 * e + 1) * RT_STR + j] = (bf16)(vw[e] >> 16); } }
        { const bf16* Su = Sb + (size_t)un * 2 * 4096;
#pragma unroll
          for (int i = 0; i < 2; ++i) { const int p = tid + 512 * i, dir = p >> 9, e = (p >> 3) & 63, part = (p & 7) * 8;
              *(LAS v4u*)(St + (dir * 64 + e) * RK_STR + part) = *(const GAS v4u*)(Su + (size_t)dir * 4096 + e * 64 + part); } }
        bf16x8 qf[2];
#pragma unroll
        for (int ks = 0; ks < 2; ++ks) qf[ks] = *(const GAS bf16x8*)(QR + (size_t)(R0 + 16 * w + l15) * 512 + h * 64 + 32 * ks + quad * 8);
        __syncthreads();
        const int iloc = 16 * w + l15;
        bf16x8 pa[4];
#pragma unroll
        for (int kk = 0; kk < 4; ++kk) { unsigned pw[4];
#pragma unroll
            for (int half = 0; half < 2; ++half) { const int jt = 2 * kk + half; f32x4 st = {0.f, 0.f, 0.f, 0.f};
#pragma unroll
                for (int ks = 0; ks < 2; ++ks) { const bf16x8 kf = *(const LAS bf16x8*)(Kn + (16 * jt + l15) * RK_STR + 32 * ks + quad * 8);
                    st = __builtin_amdgcn_mfma_f32_16x16x32_bf16(kf, qf[ks], st, 0, 0, 0); }
                float pv[4];
#pragma unroll
                for (int r = 0; r < 4; ++r) { const int jj = 16 * jt + 4 * quad + r; const int diff = iloc - jj;
                    const float dfw = diff >= 0 ? __builtin_amdgcn_exp2f(lf2 * (float)diff) : 0.f, dbw = diff <= 0 ? __builtin_amdgcn_exp2f(lb2 * (float)(-diff)) : 0.f;
                    pv[r] = st[r] * (dfw + dbw); }
                pw[2 * half] = pk2(pv[0], pv[1]); pw[2 * half + 1] = pk2(pv[2], pv[3]); }
            pa[kk] = __builtin_bit_cast(bf16x8, (v4u){pw[0], pw[1], pw[2], pw[3]}); }
        f32x4 o[4];
#pragma unroll
        for (int dt = 0; dt < 4; ++dt) {
            f32x4 ai = {0.f, 0.f, 0.f, 0.f}, af = {0.f, 0.f, 0.f, 0.f}, ab = {0.f, 0.f, 0.f, 0.f};
#pragma unroll
            for (int kk = 0; kk < 4; ++kk) { const LAS bf16* vp = Vt + (16 * dt + l15) * RT_STR + 32 * kk + 4 * quad;
                const bf16x4 lo = *(const LAS bf16x4*)vp, hi = *(const LAS bf16x4*)(vp + 16);
                const bf16x8 vb = {lo[0], lo[1], lo[2], lo[3], hi[0], hi[1], hi[2], hi[3]};
                ai = __builtin_amdgcn_mfma_f32_16x16x32_bf16(pa[kk], vb, ai, 0, 0, 0); }
#pragma unroll
            for (int ks = 0; ks < 2; ++ks) { const bf16x8 sf = *(const LAS bf16x8*)(St + (16 * dt + l15) * RK_STR + 32 * ks + quad * 8), sb = *(const LAS bf16x8*)(St + (64 + 16 * dt + l15) * RK_STR + 32 * ks + quad * 8);
                af = __builtin_amdgcn_mfma_f32_16x16x32_bf16(qf[ks], sf, af, 0, 0, 0); ab = __builtin_amdgcn_mfma_f32_16x16x32_bf16(qf[ks], sb, ab, 0, 0, 0); }
#pragma unroll
            for (int r = 0; r < 4; ++r) { const int p = 16 * w + 4 * quad + r;
                o[dt][r] = ai[r] + __builtin_amdgcn_exp2f(lf2 * (float)(p + 1)) * af[r] + __builtin_amdgcn_exp2f(lb2 * (float)(128 - p)) * ab[r]; }
        }
#pragma unroll
        for (int r = 0; r < 4; ++r) {
            float s = (o[0][r] + o[1][r]) + (o[2][r] + o[3][r]);
            s += __shfl_xor(s, 1); s += __shfl_xor(s, 2); s += __shfl_xor(s, 4); s += __shfl_xor(s, 8);
            const float mu = s * (1.0f / 64.0f);
            const float d0 = o[0][r] - mu, d1 = o[1][r] - mu, d2 = o[2][r] - mu, d3 = o[3][r] - mu;
            float q = (d0 * d0 + d1 * d1) + (d2 * d2 + d3 * d3);
            q += __shfl_xor(q, 1); q += __shfl_xor(q, 2); q += __shfl_xor(q, 4); q += __shfl_xor(q, 8);
            const float rstd = 1.0f / sqrtf(q * (1.0f / 64.0f) + EPS);
            const size_t row = (size_t)(R0 + 16 * w + 4 * quad + r);
            const float dd[4] = {d0, d1, d2, d3};
#pragma unroll
            for (int dt = 0; dt < 4; ++dt) { const float g = bf2f(GR[row * 512 + h * 64 + 16 * dt + l15]);
                MIX[row * 1024 + 512 + h * 64 + 16 * dt + l15] = (bf16)f2bf(dd[dt] * rstd * (g / (1.0f + __expf(-g)))); }
        }
        __syncthreads();
    }
}
struct Args { const float* in[18]; float* out; unsigned char* ws; };
__global__ void __launch_bounds__(NWAVES * 64, 2) hybrid_fwd(Args args) {
    extern __shared__ __attribute__((aligned(16))) unsigned char lds[];
    cg::grid_group grid = cg::this_grid();
    Frame F;
    F.lds = (LAS unsigned char*)lds;
    F.G = gridDim.x; { const int bx = blockIdx.x; F.vcu = (F.G % 8 == 0) ? (bx % 8) * (F.G / 8) + bx / 8 : bx; }
    F.x = args.in[0]; F.c = args.in[1]; F.ctx = args.in[2]; F.c_ctx = args.in[3]; F.w_mod = args.in[4]; F.b_mod = args.in[5];
    F.g_pre_mix = args.in[6]; F.g_post_mix = args.in[7]; F.g_pre_ffn = args.in[8]; F.g_post_ffn = args.in[9]; F.w_in = args.in[10];
    F.q_norm_g = args.in[11]; F.k_norm_g = args.in[12]; F.dec_f = args.in[13]; F.dec_b = args.in[14]; F.w_out = args.in[15]; F.w_f1 = args.in[16]; F.w_f2 = args.in[17];
    F.out = args.out; F.ws = args.ws;
    unsigned char* ws = args.ws;

    p0_prologue(F);
    grid.sync();
    p0b_rows(F);
    grid.sync();
    {
        pg8::Gemm g{(const pg8::bf16_t*)(ws + WS_XN), (const pg8::bf16_t*)(ws + WS_WIN), MA, NIN, D}; pg8::StaticOrder S; S.init(MA, NIN, F.G, (int)blockIdx.x);
        pg8::EpiInProj E{(pg8::bf16_t*)(ws + WS_QA), (pg8::bf16_t*)(ws + WS_KA), (pg8::bf16_t*)(ws + WS_VA), (pg8::bf16_t*)(ws + WS_QR), (pg8::bf16_t*)(ws + WS_KR), (pg8::bf16_t*)(ws + WS_VR), (pg8::bf16_t*)(ws + WS_GR),
                         F.q_norm_g, F.k_norm_g, (const float*)(ws + WS_COS), (const float*)(ws + WS_SIN), attn_body::C2};
        pg8::gemm_phase<pg8::EpiInProj, pg8::StaticOrder, true, true>(F.lds, g, S, E);
    }
    grid.sync();
    ret_local_states(F);
    grid.sync();
    ret_scan(F);
    grid.sync();
    {
        const attn_body::AttnTensors AT{(const attn_body::bf16*)(ws + WS_QA), (const attn_body::bf16*)(ws + WS_KA), (const attn_body::bf16*)(ws + WS_VA), (attn_body::bf16*)(ws + WS_MIXIN)};
        const attn_body::StaticOrder S((int)F.G, (int)blockIdx.x);
        attn_body::attn_phase<attn_body::StaticOrder>((char*)lds, AT, S);
        asm volatile("s_waitcnt vmcnt(0) lgkmcnt(0)" ::: "memory"); __syncthreads();
        ret_outputs(F);
    }
    grid.sync();
    {
        pg8::Gemm g{(const pg8::bf16_t*)(ws + WS_MIXIN), (const pg8::bf16_t*)(ws + WS_WOUT), ML, D, D}; pg8::StaticOrder S; S.init(ML, D, F.G, (int)blockIdx.x);
        pg8::EpiF32 E{(float*)(ws + WS_MIXRAW), D};
        pg8::gemm_phase<pg8::EpiF32, pg8::StaticOrder, true, true>(F.lds, g, S, E);
    }
    grid.sync();
    p5_rows(F);
    grid.sync();
    {
        pg8::Gemm g{(const pg8::bf16_t*)(ws + WS_XN), (const pg8::bf16_t*)(ws + WS_WF1), ML, 2 * FFH, D}; pg8::StaticOrder S; S.init(ML, 2 * FFH, F.G, (int)blockIdx.x);
        pg8::EpiSwiglu E{(pg8::bf16_t*)(ws + WS_HID), FFH};
        pg8::gemm_phase<pg8::EpiSwiglu, pg8::StaticOrder, true, true>(F.lds, g, S, E);
    }
    grid.sync();
    {
        pg8::Gemm g{(const pg8::bf16_t*)(ws + WS_HID), (const pg8::bf16_t*)(ws + WS_WF2), ML, D, FFH}; pg8::StaticOrder S; S.init(ML, D, F.G, (int)blockIdx.x);
        pg8::EpiF32 E{(float*)(ws + WS_FFNRAW), D};
        pg8::gemm_phase<pg8::EpiF32, pg8::StaticOrder, true, true>(F.lds, g, S, E);
    }
    grid.sync();
    p8_rows(F);
}

extern "C" void kernel_launch(void* const* d_in, const int* in_sizes, int n_in, void* d_out, int out_size, void* d_ws, size_t ws_size, hipStream_t stream) {
    static int grid = 0;
    if (grid == 0) {
        if (n_in != 18 || in_sizes[0] != ML * D || out_size != ML * D || ws_size < WS_END) { fprintf(stderr, "kernel_launch: unexpected shapes (n_in %d, in0 %d, out %d, ws %zu); nothing launched\n", n_in, n_in > 0 ? in_sizes[0] : -1, out_size, ws_size); grid = -1; return; }
        int dev = 0, cus = 0, per_cu = 0;
        if (hipGetDevice(&dev) != hipSuccess || hipDeviceGetAttribute(&cus, hipDeviceAttributeMultiprocessorCount, dev) != hipSuccess) { grid = -1; return; }
        if (hipFuncSetAttribute((const void*)hybrid_fwd, hipFuncAttributeMaxDynamicSharedMemorySize, LDS_BYTES) != hipSuccess) { fprintf(stderr, "kernel_launch: hipFuncSetAttribute failed\n"); grid = -1; return; }
        if (hipOccupancyMaxActiveBlocksPerMultiprocessor(&per_cu, (const void*)hybrid_fwd, NWAVES * 64, LDS_BYTES) != hipSuccess || per_cu < 1) { fprintf(stderr, "kernel_launch: occupancy query reports %d workgroups per CU\n", per_cu); (void)hipGetLastError(); grid = -1; return; }
        grid = cus * per_cu;
    }
    if (grid < 0) return;
    (void)hipMemsetAsync((char*)d_ws + WS_MOD, 0, 5 * 6144 * sizeof(float), stream);
    Args a{};
    for (int i = 0; i < 18; ++i) a.in[i] = (const float*)d_in[i];
    a.out = (float*)d_out; a.ws = (unsigned char*)d_ws;
    void* kargs[] = {&a};
    hipError_t e = hipLaunchCooperativeKernel((const void*)hybrid_fwd, dim3(grid), dim3(NWAVES * 64), kargs, LDS_BYTES, stream);
    if (e != hipSuccess) fprintf(stderr, "kernel_launch: cooperative launch failed: %s (grid %d)\n", hipGetErrorString(e), grid);
}
```

```cpp
#include <hip/hip_runtime.h>
#include <hip/hip_cooperative_groups.h>
#include <hip/hip_bf16.h>
#include <cstdio>
#include <cstdint>
#include <cmath>
namespace cg = cooperative_groups;
namespace pg8 {
#define PG8_LAS __attribute__((address_space(3)))
typedef unsigned short bf16_t;
typedef short bf16x8 __attribute__((ext_vector_type(8)));
typedef float f32x4 __attribute__((ext_vector_type(4)));
typedef unsigned u32x4 __attribute__((ext_vector_type(4)));
constexpr int BM = 256, BK = 64, HALF = 128, HTB = HALF * BK * 2  , STAGE_BYTES = 8 * HTB, NXCD = 8, WGM = 8;

__host__ __device__ __forceinline__ int lds_byte(int r, int c) { const int st = (r >> 4) * 2 + (c >> 5), rr = r & 15, cc = c & 31, ob = rr * 64 + cc * 2; return st * 1024 + (ob ^ (((ob >> 9) & 1) << 5)); }
__host__ __device__ __forceinline__ void stage_rc(int b, int& R, int& C) { const int st = b / 1024, sb = b % 1024, swz = sb ^ (((sb >> 9) & 1) << 5); R = (st >> 1) * 16 + swz / 64; C = (st & 1) * 32 + (swz % 64) / 2; }
__host__ __device__ __forceinline__ int perm32(int rho) { const int n = rho >> 4, i = rho & 15; return 8 * (i >> 2) + 4 * n + (i & 3); }

struct Unit { int pm, pn; };
struct Gemm { const bf16_t* A; const bf16_t* Bt; int M, N, K; };

struct StaticOrder {
    int nM, nN, nwg, G, c;
    __host__ __device__ void init(int M, int N, int G_, int c_) { nM = M / BM; nN = N / BM; nwg = nM * nN; G = G_; c = c_; }
    __host__ __device__ bool next(int i, Unit& u) const {
        const long L = (long)i * G + c; if (L >= nwg) return false;
        int wgid = (int)L; { const int q = nwg / NXCD, r = nwg % NXCD, xcd = wgid % NXCD, off = wgid / NXCD; wgid = (xcd < r ? xcd * (q + 1) : r * (q + 1) + (xcd - r) * q) + off; }
        const int nig = WGM * nN, gid = wgid / nig, fm = gid * WGM, gsz = (nM - fm) < WGM ? (nM - fm) : WGM;
        u.pm = fm + ((wgid % nig) % gsz); u.pn = (wgid % nig) / gsz; return true;
    }
    __device__ __forceinline__ void a_ready(const Unit&) const {}
    __device__ __forceinline__ void done(const Unit&) const {}
};

__device__ __forceinline__ unsigned cvt_pk_bf16(float lo, float hi) { unsigned r; asm volatile("v_cvt_pk_bf16_f32 %0, %1, %2" : "=v"(r) : "v"(lo), "v"(hi)); return r; }
typedef float f32x2 __attribute__((ext_vector_type(2)));
typedef unsigned u32x2 __attribute__((ext_vector_type(2)));
__device__ __forceinline__ float fast_sigmoid(float a) { return __builtin_amdgcn_rcpf(1.0f + __builtin_amdgcn_exp2f(-1.4426950408889634f * a)); }
struct EpiF32 {
    static constexpr bool PERM = false, AFTER_DRAIN = false;
    float* O; int ldc;
    __device__ __forceinline__ void operator()(const f32x4 (&acc)[2][2][4][2], const Unit& u, int wr, int wc, int fr, int fq) const {
        const int row0 = u.pm * BM + wr * 64 + fr, col0 = u.pn * BM + wc * 32 + 4 * fq;
#pragma unroll
        for (int ai = 0; ai < 2; ++ai)
#pragma unroll
            for (int m = 0; m < 4; ++m) { float* rowp = O + (size_t)(row0 + ai * HALF + m * 16) * ldc + col0;
#pragma unroll
                for (int bj = 0; bj < 2; ++bj)
#pragma unroll
                    for (int n = 0; n < 2; ++n) *(f32x4*)(rowp + bj * HALF + n * 16) = acc[ai][bj][m][n]; }
    }
};
struct EpiSwiglu {
    static constexpr bool PERM = true, AFTER_DRAIN = false;
    bf16_t* H; int ldh;
    __device__ __forceinline__ void operator()(const f32x4 (&acc)[2][2][4][2], const Unit& u, int wr, int wc, int fr, int fq) const {
        const int row0 = u.pm * BM + wr * 64 + fr, col0 = u.pn * HALF + wc * 32 + 8 * fq;
#pragma unroll
        for (int ai = 0; ai < 2; ++ai)
#pragma unroll
            for (int m = 0; m < 4; ++m) { bf16_t* rowp = H + (size_t)(row0 + ai * HALF + m * 16) * ldh + col0;
                f32x4 h0, h1;
#pragma unroll
                for (int e = 0; e < 4; ++e) { const float a0 = acc[ai][0][m][0][e], a1 = acc[ai][0][m][1][e];
                    h0[e] = a0 * fast_sigmoid(a0) * acc[ai][1][m][0][e]; h1[e] = a1 * fast_sigmoid(a1) * acc[ai][1][m][1][e]; }
                u32x4 w; w.x = cvt_pk_bf16(h0[0], h0[1]); w.y = cvt_pk_bf16(h0[2], h0[3]); w.z = cvt_pk_bf16(h1[0], h1[1]); w.w = cvt_pk_bf16(h1[2], h1[3]);
                *(u32x4*)rowp = w; }
    }
};
struct EpiInProj {
    static constexpr bool PERM = true, AFTER_DRAIN = false;
    bf16_t *QA, *KA, *VA, *QR, *KR, *VR, *GR; const float *qg, *kg, *cosT, *sinT; float qscale;
    __device__ __forceinline__ void operator()(const f32x4 (&acc)[2][2][4][2], const Unit& u, int wr, int wc, int fr, int fq) const {
        const int g = u.pn * 4 + wc; const bool isctx = u.pm >= 128;
        int kind, gl; bf16_t* base; int pitch = 512;
        if (g < 8) { kind = 0; gl = g; base = QA; } else if (g < 10) { kind = 1; gl = g - 8; base = KA; pitch = 128; } else if (g < 12) { kind = 2; gl = g - 10; base = VA; pitch = 128; }
        else if (g < 20) { kind = 3; gl = g - 12; base = QR; } else if (g < 28) { kind = 4; gl = g - 20; base = KR; } else if (g < 36) { kind = 5; gl = g - 28; base = VR; } else { kind = 6; gl = g - 36; base = GR; }
        const bool donorm = kind <= 1, dorope = !isctx && (kind == 0 || kind == 1 || kind == 3 || kind == 4);
        const float osc = kind == 0 ? qscale : (kind == 4 ? 0.125f : 1.0f);
        const int j0 = 8 * fq;
        const float* gsrc = kind == 0 ? qg : kg;
#pragma unroll
        for (int ai = 0; ai < 2; ++ai)
#pragma unroll
            for (int m = 0; m < 4; ++m) {
                const int row = u.pm * BM + ai * HALF + wr * 64 + m * 16 + fr;
                float rstd = 1.0f;
                if (donorm) {
                    float ss = 0.f;
#pragma unroll
                    for (int bj = 0; bj < 2; ++bj)
#pragma unroll
                        for (int n = 0; n < 2; ++n) { const f32x4 t = acc[ai][bj][m][n]; ss += (t[0] * t[0] + t[1] * t[1]) + (t[2] * t[2] + t[3] * t[3]); }
                    ss += __shfl_xor(ss, 16); ss += __shfl_xor(ss, 32);
                    rstd = 1.0f / sqrtf(ss * (1.0f / 64.0f) + 1e-6f);
                }
                size_t drow;
                if (kind == 1 || kind == 2) { drow = isctx ? (size_t)((row - 32768) >> 8) * 8448 + ((row - 32768) & 255) : (size_t)(row >> 13) * 8448 + 256 + (row & 8191); }
                else drow = (size_t)row;
                bf16_t* dp = base + drow * pitch + gl * 64 + j0;
                const int pos = row & 8191;
#pragma unroll
                for (int n = 0; n < 2; ++n) {
                    f32x4 x1 = acc[ai][0][m][n], x2 = acc[ai][1][m][n];
                    if (donorm) { x1 = x1 * rstd * *(const f32x4*)(gsrc + j0 + 4 * n); x2 = x2 * rstd * *(const f32x4*)(gsrc + 32 + j0 + 4 * n); }
                    if (dorope) { const f32x4 c = *(const f32x4*)(cosT + pos * 32 + j0 + 4 * n), s = *(const f32x4*)(sinT + pos * 32 + j0 + 4 * n);
                        const f32x4 y1 = x1 * c - x2 * s, y2 = x1 * s + x2 * c; x1 = y1; x2 = y2; }
                    x1 = x1 * osc; x2 = x2 * osc;
                    u32x2 w1, w2; w1.x = cvt_pk_bf16(x1[0], x1[1]); w1.y = cvt_pk_bf16(x1[2], x1[3]); w2.x = cvt_pk_bf16(x2[0], x2[1]); w2.y = cvt_pk_bf16(x2[2], x2[3]);
                    *(u32x2*)(dp + 4 * n) = w1; *(u32x2*)(dp + 32 + 4 * n) = w2;
                }
            }
    }
};
template <class Epi, class Sched, bool ALIGN_EPI = false, bool SP2 = false>
__device__ __forceinline__ void gemm_phase(PG8_LAS unsigned char* lds, const Gemm g, const Sched& S, const Epi& E) {
    int tid_ = threadIdx.x; asm volatile("" : "+v"(tid_)); const int tid = tid_, wid = __builtin_amdgcn_readfirstlane(tid >> 6), lane = tid & 63, wr = wid >> 2, wc = wid & 3, fr = lane & 15, fq = lane >> 4;
    const int K = g.K, nt = K / BK;
    unsigned voffA[2], voffB[2];
#pragma unroll
    for (int i = 0; i < 2; ++i) { int R, C; stage_rc(tid * 16 + i * 8192, R, C); const int Rb = Epi::PERM ? ((R & ~31) + perm32(R & 31)) : R;
        voffA[i] = (unsigned)(R * K + C) * 2u; voffB[i] = (unsigned)(Rb * K + C) * 2u; }
    const size_t kstep = (size_t)(BK * 2);
    const size_t hstep = (size_t)HALF * K * 2;
    const size_t tstep = 2 * hstep;
    const unsigned ldsw = (unsigned)wid * 1024u;
    const int aoff = lds_byte(wr * 64 + fr, fq * 8), boff = lds_byte(wc * 32 + fr, fq * 8);
#define PG8_SA(b, h) (((b) * 2 + (h)) * HTB)
#define PG8_SB(b, h) ((4 + (b) * 2 + (h)) * HTB)
#define PG8_STAGE(bufoff, gbase, voff) do { _Pragma("unroll") for (int _i = 0; _i < 2; ++_i) \
        __builtin_amdgcn_global_load_lds((const unsigned*)((const char*)(gbase) + (voff)[_i]), (PG8_LAS unsigned*)(lds + (bufoff) + ldsw + _i * 8192), 16, 0, 0); } while (0)
#define PG8_LDA(dst, b, h) do { _Pragma("unroll") for (int m = 0; m < 4; ++m) _Pragma("unroll") for (int k = 0; k < 2; ++k) dst[m][k] = *(const PG8_LAS bf16x8*)(lds + PG8_SA(b, h) + aoff + m * 2048 + k * 1024); } while (0)
#define PG8_LDB(dst, b, h) do { _Pragma("unroll") for (int n = 0; n < 2; ++n) _Pragma("unroll") for (int k = 0; k < 2; ++k) dst[n][k] = *(const PG8_LAS bf16x8*)(lds + PG8_SB(b, h) + boff + n * 2048 + k * 1024); } while (0)
#define PG8_MMA(ai, bj, At, Bt) do { __builtin_amdgcn_s_setprio(1); _Pragma("unroll") for (int m = 0; m < 4; ++m) _Pragma("unroll") for (int n = 0; n < 2; ++n) _Pragma("unroll") for (int k = 0; k < 2; ++k) \
        acc[ai][bj][m][n] = __builtin_amdgcn_mfma_f32_16x16x32_bf16(Bt[n][k], At[m][k], acc[ai][bj][m][n], 0, 0, 0); __builtin_amdgcn_s_setprio(0); } while (0)
#define PG8_WAIT_V(n) asm volatile("s_waitcnt vmcnt(" #n ")" ::: "memory")
#define PG8_WAIT_L(n) asm volatile("s_waitcnt lgkmcnt(" #n ")" ::: "memory")
#define PG8_BAR __builtin_amdgcn_s_barrier()
#define PG8_SCHED __builtin_amdgcn_sched_barrier(0)
    Unit cur, nxt; int ui = 0;
    if (!S.next(0, cur)) return;
    f32x4 acc[2][2][4][2];
#pragma unroll
    for (int a = 0; a < 2; ++a)
#pragma unroll
        for (int b = 0; b < 2; ++b)
#pragma unroll
            for (int m = 0; m < 4; ++m)
#pragma unroll
                for (int n = 0; n < 2; ++n) acc[a][b][m][n] = (f32x4){0.f, 0.f, 0.f, 0.f};
    bf16x8 At[4][2], B0[2][2], B1[2][2];
    const char* cA = (const char*)g.A + (size_t)cur.pm * tstep; const char* cB = (const char*)g.Bt + (size_t)cur.pn * tstep;
    S.a_ready(cur);
    if constexpr (SP2) {
        PG8_STAGE(PG8_SB(0, 0), cB, voffB); PG8_STAGE(PG8_SB(0, 1), cB + hstep, voffB); PG8_STAGE(PG8_SA(0, 0), cA, voffA); PG8_STAGE(PG8_SA(0, 1), cA + hstep, voffA);
        if (wr == 1) PG8_BAR;
        PG8_WAIT_V(2); PG8_BAR;
        PG8_STAGE(PG8_SB(1, 0), cB + kstep, voffB); PG8_STAGE(PG8_SA(1, 0), cA + kstep, voffA); PG8_STAGE(PG8_SB(1, 1), cB + hstep + kstep, voffB);
        PG8_WAIT_V(6); PG8_BAR;
    } else {
        PG8_STAGE(PG8_SB(0, 0), cB, voffB); PG8_STAGE(PG8_SA(0, 0), cA, voffA); PG8_STAGE(PG8_SB(0, 1), cB + hstep, voffB); PG8_STAGE(PG8_SA(0, 1), cA + hstep, voffA);
        if (wr == 1) PG8_BAR;
        PG8_WAIT_V(4); PG8_BAR;
        PG8_STAGE(PG8_SB(1, 0), cB + kstep, voffB); PG8_STAGE(PG8_SA(1, 0), cA + kstep, voffA); PG8_STAGE(PG8_SB(1, 1), cB + hstep + kstep, voffB);
        PG8_WAIT_V(6); PG8_BAR;
    }
    for (;;) {
        const bool has_next = S.next(ui + 1, nxt);
        const char* nA = has_next ? (const char*)g.A + (size_t)nxt.pm * tstep : cA; const char* nB = has_next ? (const char*)g.Bt + (size_t)nxt.pn * tstep : cB;
        for (int t = 0; t < nt; t += 2) {
            const bool last = (t == nt - 2);
            const char* a1 = cA + (size_t)(t + 1) * kstep;
            const char* a2 = last ? nA : cA + (size_t)(t + 2) * kstep; const char* b2 = last ? nB : cB + (size_t)(t + 2) * kstep;
            const char* a3 = a2 + kstep; const char* b3 = b2 + kstep;
            if (last && has_next) S.a_ready(nxt);
            if constexpr (SP2) {
            PG8_LDB(B0, 0, 0); PG8_LDB(B1, 0, 1); PG8_SCHED; PG8_LDA(At, 0, 0); PG8_STAGE(PG8_SA(1, 1), a1 + hstep, voffA);
            PG8_WAIT_V(8); PG8_WAIT_L(0); PG8_BAR; PG8_MMA(0, 0, At, B0); PG8_MMA(0, 1, At, B1); PG8_BAR; PG8_SCHED;
            PG8_LDA(At, 0, 1); PG8_STAGE(PG8_SB(0, 0), b2, voffB); PG8_STAGE(PG8_SB(0, 1), b2 + hstep, voffB); PG8_STAGE(PG8_SA(0, 0), a2, voffA);
            PG8_WAIT_V(8); PG8_WAIT_L(0); PG8_BAR; PG8_MMA(1, 0, At, B0); PG8_MMA(1, 1, At, B1); PG8_BAR; PG8_SCHED;
            PG8_LDB(B0, 1, 0); PG8_LDB(B1, 1, 1); PG8_SCHED; PG8_LDA(At, 1, 0); PG8_STAGE(PG8_SA(0, 1), a2 + hstep, voffA);
            PG8_WAIT_V(8); PG8_WAIT_L(0); PG8_BAR; PG8_MMA(0, 0, At, B0); PG8_MMA(0, 1, At, B1); PG8_BAR; PG8_SCHED;
            PG8_LDA(At, 1, 1); PG8_STAGE(PG8_SB(1, 0), b3, voffB); PG8_STAGE(PG8_SB(1, 1), b3 + hstep, voffB); PG8_STAGE(PG8_SA(1, 0), a3, voffA);
            PG8_WAIT_V(8); PG8_WAIT_L(0); PG8_BAR; PG8_MMA(1, 0, At, B0); PG8_MMA(1, 1, At, B1); PG8_BAR; PG8_SCHED;
            } else {
            PG8_LDB(B0, 0, 0); PG8_SCHED; PG8_LDA(At, 0, 0); PG8_STAGE(PG8_SA(1, 1), a1 + hstep, voffA);
            PG8_WAIT_L(8); PG8_BAR; PG8_WAIT_L(0); PG8_MMA(0, 0, At, B0); PG8_BAR; PG8_SCHED;
            PG8_LDB(B1, 0, 1); PG8_STAGE(PG8_SB(0, 0), b2, voffB);
            PG8_BAR; PG8_WAIT_L(0); PG8_MMA(0, 1, At, B1); PG8_BAR;
            PG8_LDA(At, 0, 1); PG8_STAGE(PG8_SA(0, 0), a2, voffA);
            PG8_BAR; PG8_WAIT_L(0); PG8_MMA(1, 0, At, B0); PG8_BAR; PG8_SCHED;
            PG8_STAGE(PG8_SB(0, 1), b2 + hstep, voffB);
            PG8_WAIT_V(6); PG8_BAR; PG8_MMA(1, 1, At, B1); PG8_BAR;
            PG8_LDB(B0, 1, 0); PG8_SCHED; PG8_LDA(At, 1, 0); PG8_STAGE(PG8_SA(0, 1), a2 + hstep, voffA);
            PG8_WAIT_L(8); PG8_BAR; PG8_WAIT_L(0); PG8_MMA(0, 0, At, B0); PG8_BAR; PG8_SCHED;
            PG8_LDB(B1, 1, 1); PG8_STAGE(PG8_SB(1, 0), b3, voffB);
            PG8_BAR; PG8_WAIT_L(0); PG8_MMA(0, 1, At, B1); PG8_BAR;
            PG8_LDA(At, 1, 1); PG8_STAGE(PG8_SA(1, 0), a3, voffA);
            PG8_BAR; PG8_WAIT_L(0); PG8_MMA(1, 0, At, B0); PG8_BAR; PG8_SCHED;
            PG8_STAGE(PG8_SB(1, 1), b3 + hstep, voffB);
            PG8_WAIT_V(6); PG8_BAR; PG8_MMA(1, 1, At, B1); PG8_BAR;
            }
        }
        if constexpr (ALIGN_EPI) { if (wr == 0) PG8_BAR; }
        if constexpr (!Epi::AFTER_DRAIN) { E(acc, cur, wr, wc, fr, fq); S.done(cur); }
        if (!has_next) break;
#pragma unroll
        for (int a = 0; a < 2; ++a)
#pragma unroll
            for (int b = 0; b < 2; ++b)
#pragma unroll
                for (int m = 0; m < 4; ++m)
#pragma unroll
                    for (int n = 0; n < 2; ++n) acc[a][b][m][n] = (f32x4){0.f, 0.f, 0.f, 0.f};
        cur = nxt; cA = nA; cB = nB; ++ui;
        if constexpr (ALIGN_EPI) { if (wr == 1) PG8_BAR; }
    }
    PG8_WAIT_V(0);
    if constexpr (!ALIGN_EPI) { if (wr == 0) PG8_BAR; }
    PG8_BAR;
    if constexpr (Epi::AFTER_DRAIN) { E.fused(acc, cur, wr, wc, fr, fq, lds, wid, lane); S.done(cur); }
#undef PG8_SA
#undef PG8_SB
#undef PG8_STAGE
#undef PG8_LDA
#undef PG8_LDB
#undef PG8_MMA
#undef PG8_WAIT_V
#undef PG8_WAIT_L
#undef PG8_BAR
#undef PG8_SCHED
}
}
#include <hip/hip_bf16.h>
#include <cmath>
namespace attn_body {
using bf16=__hip_bfloat16;
using bf16x8=__attribute__((ext_vector_type(8)))short;
using s16x4=__attribute__((ext_vector_type(4)))short;
using f32x16=__attribute__((ext_vector_type(16)))float;
using u32x4=__attribute__((ext_vector_type(4)))unsigned;
constexpr int BATCH=4,NHEAD=8,SEQQ=8192,SEQK=8448,D=64,QP=512,KP=128,OP=1024;
constexpr int NW=8,QBLK=32,QB=QBLK*NW,KVBLK=64,NQB=SEQQ/QB;
constexpr int ATTN_UNIT_ROWS=QB;
__device__ __forceinline__ int crow(int r,int hi){return (r&3)+8*(r>>2)+4*hi;}
#define SBAR() __builtin_amdgcn_sched_barrier(0)
__device__ __forceinline__ void cmask(f32x16&p0,f32x16&p1,int jb,int qrel,int hi){
  const float NEG=-INFINITY; int kb=64*jb+4*hi;
  #pragma unroll
  for(int r=0;r<16;++r){int kv=kb+(r&3)+8*(r>>2); if(kv>qrel)p0[r]=NEG; if(kv+32>qrel)p1[r]=NEG;}
}

constexpr int NSLOT=3, SLOTB=8192;
constexpr int LDS_K=0, LDS_V=NSLOT*SLOTB, LDS_WS=2*NSLOT*SLOTB, LDS_OST=LDS_WS+NW*64*4, LDS_BYTES=LDS_OST+NW*4096;
constexpr float C2=0.125f*1.4426950408889634f;
__device__ __forceinline__ void glds16(const void*gsrc,unsigned lds_dst){unsigned keep;
  asm volatile("s_mov_b32 %0, m0\n\ts_mov_b32 m0, %2\n\ts_nop 0\n\tglobal_load_lds_dwordx4 %1, off\n\ts_mov_b32 m0, %0":"=&s"(keep):"v"(gsrc),"s"(lds_dst):"memory");}
__device__ __forceinline__ float max3f(float a,float b,float c){float r;asm("v_max3_f32 %0, %1, %2, %3":"=v"(r):"v"(a),"v"(b),"v"(c));return r;}
__device__ __forceinline__ float max2f(float a,float b){float r;asm("v_max_f32_e32 %0, %1, %2":"=v"(r):"v"(a),"v"(b));return r;}
__device__ __forceinline__ float fadd_s(float a,float b){float r;asm("v_add_f32_e32 %0, %1, %2":"=v"(r):"v"(a),"v"(b));return r;}
__device__ __forceinline__ float fsub_s(float a,float b){float r;asm("v_sub_f32_e32 %0, %1, %2":"=v"(r):"v"(a),"v"(b));return r;}
typedef float f32x2_t __attribute__((ext_vector_type(2))); typedef __bf16 bf16x2_t __attribute__((ext_vector_type(2)));
__device__ __forceinline__ unsigned cvtpk_s(float lo,float hi){f32x2_t v={lo,hi};bf16x2_t b=__builtin_convertvector(v,bf16x2_t);return __builtin_bit_cast(unsigned,b);}
#define WAIT_BAR(N) asm volatile("s_waitcnt vmcnt(" #N ") lgkmcnt(0)\n\ts_barrier":::"memory")

__device__ __forceinline__ void qkt(f32x16&p0,f32x16&p1,const char*Kslot,const bf16x8*qr,const f32x16&negm,int r32,int hi){
  const char*kb=Kslot+hi*1024+r32*16;
  #pragma unroll
  for(int d0=0;d0<4;++d0){
    const bf16x8 b0=*reinterpret_cast<const bf16x8*>(kb+d0*2048);
    const bf16x8 b1=*reinterpret_cast<const bf16x8*>(kb+d0*2048+512);
    if(d0==0){p0=__builtin_amdgcn_mfma_f32_32x32x16_bf16(b0,qr[0],negm,0,0,0);p1=__builtin_amdgcn_mfma_f32_32x32x16_bf16(b1,qr[0],negm,0,0,0);}
    else{p0=__builtin_amdgcn_mfma_f32_32x32x16_bf16(b0,qr[d0],p0,0,0,0);p1=__builtin_amdgcn_mfma_f32_32x32x16_bf16(b1,qr[d0],p1,0,0,0);}}
}
typedef __attribute__((address_space(3))) const char* lds_cptr;
typedef short v4i16_t __attribute__((ext_vector_type(4)));
__device__ __forceinline__ void kload8(bf16x8*kf,lds_cptr kp){
  kf[0]=*(const __attribute__((address_space(3))) bf16x8*)(kp);      kf[1]=*(const __attribute__((address_space(3))) bf16x8*)(kp+512);
  kf[2]=*(const __attribute__((address_space(3))) bf16x8*)(kp+2048); kf[3]=*(const __attribute__((address_space(3))) bf16x8*)(kp+2560);
  kf[4]=*(const __attribute__((address_space(3))) bf16x8*)(kp+4096); kf[5]=*(const __attribute__((address_space(3))) bf16x8*)(kp+4608);
  kf[6]=*(const __attribute__((address_space(3))) bf16x8*)(kp+6144); kf[7]=*(const __attribute__((address_space(3))) bf16x8*)(kp+6656);
}
__device__ __forceinline__ void kload2(bf16x8*kf,lds_cptr kp,int j){ kf[2*j]=*(const __attribute__((address_space(3))) bf16x8*)(kp+j*2048); kf[2*j+1]=*(const __attribute__((address_space(3))) bf16x8*)(kp+j*2048+512); }
__device__ __forceinline__ s16x4 vtr(lds_cptr p){ return __builtin_bit_cast(s16x4,__builtin_amdgcn_ds_read_tr16_b64_v4i16((__attribute__((address_space(3))) v4i16_t*)p)); }
__device__ __forceinline__ float rowmax(const f32x16&p0,const f32x16&p1){
  float a=max3f(p0[0],p0[1],p1[0]),b=max3f(p0[2],p0[3],p1[1]);a=max3f(a,p1[2],p1[3]);
  #pragma unroll
  for(int r=4;r<16;r+=4){a=max3f(a,p0[r],p0[r+1]);b=max3f(b,p0[r+2],p0[r+3]);a=max3f(a,p1[r],p1[r+1]);b=max3f(b,p1[r+2],p1[r+3]);}
  const float m=max2f(a,b);
  auto rr=__builtin_amdgcn_permlane32_swap(__float_as_uint(m),__float_as_uint(m),false,false);
  return max2f(__uint_as_float(rr[0]),__uint_as_float(rr[1]));
}
__device__ __forceinline__ void pv(f32x16*o,int vb,bf16x8 pa0,bf16x8 pa1,bf16x8 pa2,bf16x8 pa3){
  #pragma unroll
  for(int d0=0;d0<2;++d0){s16x4 lo[4],hi[4];
    #pragma unroll
    for(int ks=0;ks<4;++ks){
      asm volatile("ds_read_b64_tr_b16 %0,%1 offset:%c2":"=&v"(lo[ks]):"v"(vb),"i"(d0*4096+ks*1024):"memory");
      asm volatile("ds_read_b64_tr_b16 %0,%1 offset:%c2":"=&v"(hi[ks]):"v"(vb),"i"(d0*4096+ks*1024+512):"memory");}
    asm volatile("s_waitcnt lgkmcnt(0)":::"memory");SBAR();
    #define PK(k) (bf16x8){lo[k][0],lo[k][1],lo[k][2],lo[k][3],hi[k][0],hi[k][1],hi[k][2],hi[k][3]}
    o[d0]=__builtin_amdgcn_mfma_f32_32x32x16_bf16(pa0,PK(0),o[d0],0,0,0);
    o[d0]=__builtin_amdgcn_mfma_f32_32x32x16_bf16(pa1,PK(1),o[d0],0,0,0);
    o[d0]=__builtin_amdgcn_mfma_f32_32x32x16_bf16(pa2,PK(2),o[d0],0,0,0);
    o[d0]=__builtin_amdgcn_mfma_f32_32x32x16_bf16(pa3,PK(3),o[d0],0,0,0);
    #undef PK
  }
}

#ifndef ATTN_STORE16
#define ATTN_STORE16(p,v) (*(u32x4*)(p)=(v))
#endif
template<int THRL> __device__ __forceinline__ void attn_unit(int b,int h,int qb,const bf16*Q,const bf16*__restrict__ K,const bf16*__restrict__ V,bf16*O,char*shm){
  int tid_=threadIdx.x; asm volatile("":"+v"(tid_)); const int tid=tid_,lane=tid&63,r32=lane&31,hi=lane>>5; const int wid=__builtin_amdgcn_readfirstlane(tid>>6);
  const int q0=qb*QB; const long qrow=(long)b*SEQQ+q0+wid*QBLK; const int kvh=h>>2;
  const bf16*Qw=Q+qrow*QP+h*D;
  const bf16*Kh=K+(long)b*SEQK*KP+kvh*D,*Vh=V+(long)b*SEQK*KP+kvh*D;
  const unsigned lds0=(unsigned)(uintptr_t)shm;
  float*wsf=(float*)(shm+LDS_WS)+wid*64;
  const bf16*ksrc=Kh+(long)lane*KP+wid*8;
  const bf16*vsrc=Vh+(long)(16*(wid&3)+(lane>>2))*KP+(wid>>2)*32+(lane&3)*8;
  const unsigned kdst=lds0+LDS_K+wid*1024, vdst=lds0+LDS_V+wid*1024;
  #define DMA_K(t,slot) glds16(ksrc+(long)(t)*KVBLK*KP,(unsigned)__builtin_amdgcn_readfirstlane(kdst+(slot)))
  #define DMA_V(t,slot) glds16(vsrc+(long)(t)*KVBLK*KP,(unsigned)__builtin_amdgcn_readfirstlane(vdst+(slot)))
  const int vb0=(int)(lds0+LDS_V)+((lane>>4)&1)*32+(lane&3)*8+(4*hi+((lane&15)>>2))*64;
  const char*Kbase=shm+LDS_K; bf16x8 kf[8];
  const lds_cptr shm3=(lds_cptr)shm; const lds_cptr kp0=shm3+LDS_K+hi*1024+r32*16; const lds_cptr vp0=shm3+LDS_V+((lane>>4)&1)*32+(lane&3)*8+(4*hi+((lane&15)>>2))*64;
  constexpr int NT=SEQK/KVBLK;
  DMA_K(0,0);DMA_V(0,0);DMA_K(1,SLOTB);
  bf16x8 qr[4];
  #pragma unroll
  for(int d0=0;d0<4;++d0)qr[d0]=*reinterpret_cast<const bf16x8*>(&Qw[(long)r32*QP+d0*16+hi*8]);
  float mhat=0.f,l_reg=0.f;f32x16 o[2];o[0]=f32x16{};o[1]=f32x16{};f32x16 negm=f32x16{};asm volatile("":"+v"(negm));
  #define CMASK(P0,P1,t) do{}while(0)
  bool resc=false;
  #define START(P0,P1) do{ const float rm=rowmax(P0,P1); resc=false; \
    { const float dl=rm; mhat=fadd_s(mhat,dl); \
      _Pragma("unroll") for(int r=0;r<16;++r){P0[r]=fsub_s(P0[r],dl);P1[r]=fsub_s(P1[r],dl);} \
      _Pragma("unroll") for(int r=0;r<16;++r)negm[r]=-mhat; asm volatile("":"+v"(negm)); } \
    _Pragma("unroll") for(int r=0;r<16;++r)P0[r]=__builtin_amdgcn_exp2f(P0[r]); }while(0)
  #define RESC() do{ if(resc){ asm volatile("s_waitcnt lgkmcnt(0)":::"memory"); \
      _Pragma("unroll") for(int d_=0;d_<2;++d_) _Pragma("unroll") for(int r=0;r<16;++r)o[d_][r]*=wsf[crow(r,hi)]; } }while(0)
  f32x16 pA0,pA1,pB0,pB1;
  int sl_prev=0,sl_cur=0,sl_next=SLOTB;
  #define ROT() do{sl_prev=sl_cur;sl_cur=sl_next;sl_next=(sl_next==(NSLOT-1)*SLOTB)?0:sl_next+SLOTB;}while(0)
  DMA_K(2,2*SLOTB);
  WAIT_BAR(3);
  qkt(pA0,pA1,Kbase,qr,negm,r32,hi);asm volatile("s_nop 15\n\ts_nop 7":"+v"(pA0),"+v"(pA1));CMASK(pA0,pA1,0);
  START(pA0,pA1);
  _Pragma("unroll") for(int r=0;r<16;++r)pA1[r]=__builtin_amdgcn_exp2f(pA1[r]);
  WAIT_BAR(0);
  DMA_K(3,0);DMA_V(1,SLOTB);
  ROT();
  kload8(kf,kp0+sl_cur);
  WAIT_BAR(2);
  s16x4 vlo[8],vhi[8]; u32x4 pw0,pw1,pw2,pw3;
  #define PKW(P,B) cvtpk_s(P[B],P[B+1])
  #define PAF(k) __builtin_bit_cast(bf16x8,pw##k)
  #define VFR(i) (bf16x8){vlo[i][0],vlo[i][1],vlo[i][2],vlo[i][3],vhi[i][0],vhi[i][1],vhi[i][2],vhi[i][3]}
  #define PIN(x) asm volatile("":"+v"(x))
  #define MX3(a,b,c) __builtin_fmaxf(__builtin_fmaxf((a),(b)),(c))
  #define GAPA(MF,A0,A1,A2,A3,W0,W1,PW) do{ MF; sacc+=A0; sacc+=A1; sacc+=A2; sacc+=A3; PIN(sacc); W0; W1; PIN(PW); SBAR(); }while(0)
  #define EX(v) __builtin_amdgcn_exp2f(v)
  #define GAPB(MF,X,B) do{ MF; X[B]=EX(X[B]); X[B+1]=EX(X[B+1]); X[B+2]=EX(X[B+2]); X[B+3]=EX(X[B+3]); PIN(X); SBAR(); }while(0)
  #define VRD(i) do{ vlo[i]=vtr(vp_+(((i)>>2)*4096+((i)&3)*1024)); vhi[i]=vtr(vp_+(((i)>>2)*4096+((i)&3)*1024+512)); }while(0)
  #define KRD(G,j) do{ if(G){ kload2(kf,kp0+sl_next,j); SBAR(); } }while(0)
  #define STEP(C0,C1,P0,P1,t,GK,GV,GL) do{ SBAR(); \
    const lds_cptr vp_=vp0+sl_prev; \
    VRD(0); SBAR(); float sacc=(P0[0]+P0[1]); \
    GAPA(C0=__builtin_amdgcn_mfma_f32_32x32x16_bf16(kf[0],qr[0],negm,0,0,0), P0[2],P0[3],P0[4],P0[5],     pw0[0]=PKW(P0,0), pw0[1]=PKW(P0,2), pw0); \
    VRD(4); SBAR(); GAPA(C1=__builtin_amdgcn_mfma_f32_32x32x16_bf16(kf[1],qr[0],negm,0,0,0), P0[6],P0[7],P0[8],P0[9],     pw0[2]=PKW(P0,4), pw0[3]=PKW(P0,6), pw0); \
    VRD(1); SBAR(); GAPA(C0=__builtin_amdgcn_mfma_f32_32x32x16_bf16(kf[2],qr[1],C0,0,0,0),   P0[10],P0[11],P0[12],P0[13], pw1[0]=PKW(P0,8), pw1[1]=PKW(P0,10), pw1); \
    VRD(5); SBAR(); GAPA(C1=__builtin_amdgcn_mfma_f32_32x32x16_bf16(kf[3],qr[1],C1,0,0,0),   P0[14],P0[15],P1[0],P1[1],   pw1[2]=PKW(P0,12),pw1[3]=PKW(P0,14), pw1); \
    VRD(2); SBAR(); GAPA(C0=__builtin_amdgcn_mfma_f32_32x32x16_bf16(kf[4],qr[2],C0,0,0,0),   P1[2],P1[3],P1[4],P1[5],     pw2[0]=PKW(P1,0), pw2[1]=PKW(P1,2), pw2); \
    VRD(6); SBAR(); GAPA(C1=__builtin_amdgcn_mfma_f32_32x32x16_bf16(kf[5],qr[2],C1,0,0,0),   P1[6],P1[7],P1[8],P1[9],     pw2[2]=PKW(P1,4), pw2[3]=PKW(P1,6), pw2); \
    VRD(3); SBAR(); GAPA(C0=__builtin_amdgcn_mfma_f32_32x32x16_bf16(kf[6],qr[3],C0,0,0,0),   P1[10],P1[11],P1[12],P1[13], pw3[0]=PKW(P1,8), pw3[1]=PKW(P1,10), pw3); \
    VRD(7); SBAR(); GAPA(C1=__builtin_amdgcn_mfma_f32_32x32x16_bf16(kf[7],qr[3],C1,0,0,0),   P1[14],P1[15],0.f,0.f,       pw3[2]=PKW(P1,12),pw3[3]=PKW(P1,14), pw3); \
    l_reg+=sacc; \
    if(GK){DMA_K((t)+3,sl_cur);} if(GV){DMA_V((t)+1,sl_next);} \
    CMASK(C0,C1,t); \
    { float a=MX3(C0[0],C0[1],C1[0]),b=MX3(C0[2],C0[3],C1[1]); a=MX3(a,C1[2],C1[3]); \
      _Pragma("unroll") for(int r=4;r<16;r+=4){a=MX3(a,C0[r],C0[r+1]);b=MX3(b,C0[r+2],C0[r+3]);a=MX3(a,C1[r],C1[r+1]);b=MX3(b,C1[r+2],C1[r+3]);} \
      float rm=__builtin_fmaxf(a,b); { auto rr=__builtin_amdgcn_permlane32_swap(__float_as_uint(rm),__float_as_uint(rm),false,false); rm=__builtin_fmaxf(__uint_as_float(rr[0]),__uint_as_float(rr[1])); } \
      resc=false; \
      if(__builtin_expect(__any(rm>(float)THRL),0)){ const float dl=__builtin_fmaxf(rm,0.f); mhat+=dl; \
        _Pragma("unroll") for(int r=0;r<16;++r){C0[r]-=dl;C1[r]-=dl;} \
        _Pragma("unroll") for(int r=0;r<16;++r)negm[r]=-mhat; asm volatile("":"+v"(negm)); \
        const float f=__builtin_amdgcn_exp2f(-dl); l_reg*=f; if(hi==0)wsf[r32]=f; resc=true; } } \
    SBAR(); \
    GAPB(o[0]=__builtin_amdgcn_mfma_f32_32x32x16_bf16(PAF(0),VFR(0),o[0],0,0,0), C0,0); \
    GAPB(o[1]=__builtin_amdgcn_mfma_f32_32x32x16_bf16(PAF(0),VFR(4),o[1],0,0,0), C0,4); \
    KRD(GL,0); GAPB(o[0]=__builtin_amdgcn_mfma_f32_32x32x16_bf16(PAF(1),VFR(1),o[0],0,0,0), C0,8); \
    KRD(GL,1); GAPB(o[1]=__builtin_amdgcn_mfma_f32_32x32x16_bf16(PAF(1),VFR(5),o[1],0,0,0), C0,12); \
    KRD(GL,2); GAPB(o[0]=__builtin_amdgcn_mfma_f32_32x32x16_bf16(PAF(2),VFR(2),o[0],0,0,0), C1,0); \
    KRD(GL,3); GAPB(o[1]=__builtin_amdgcn_mfma_f32_32x32x16_bf16(PAF(2),VFR(6),o[1],0,0,0), C1,4); \
    GAPB(o[0]=__builtin_amdgcn_mfma_f32_32x32x16_bf16(PAF(3),VFR(3),o[0],0,0,0), C1,8); \
    GAPB(o[1]=__builtin_amdgcn_mfma_f32_32x32x16_bf16(PAF(3),VFR(7),o[1],0,0,0), C1,12); \
    }while(0)
  int t=1;
  #undef CMASK
  #define CMASK(P0,P1,t) do{}while(0)
  for(;t+5<NT;t+=2){
    STEP(pB0,pB1,pA0,pA1,t,true,true,true);     WAIT_BAR(2); RESC(); ROT();
    STEP(pA0,pA1,pB0,pB1,t+1,true,true,true);   WAIT_BAR(2); RESC(); ROT();
  }
  #undef CMASK
  #define CMASK(P0,P1,t) do{}while(0)
  #define ENDW(tt) do{ if((tt)+3<NT){WAIT_BAR(2);} else if((tt)+2<NT){WAIT_BAR(1);} else {WAIT_BAR(0);} }while(0)
  for(;t+1<NT;t+=2){
    STEP(pB0,pB1,pA0,pA1,t,(t+3<NT),(t+1<NT),(t+1<NT));       ENDW(t);   RESC(); ROT();
    STEP(pA0,pA1,pB0,pB1,t+1,(t+4<NT),(t+2<NT),(t+2<NT));     ENDW(t+1); RESC(); ROT();
  }
  STEP(pB0,pB1,pA0,pA1,NT-1,false,false,false); RESC();
  { float sacc=pB0[0]+pB0[1]; _Pragma("unroll") for(int r=2;r<16;++r)sacc+=pB0[r]; _Pragma("unroll") for(int r=0;r<16;++r)sacc+=pB1[r]; l_reg+=sacc;
    pw0=(u32x4){PKW(pB0,0),PKW(pB0,2),PKW(pB0,4),PKW(pB0,6)};pw1=(u32x4){PKW(pB0,8),PKW(pB0,10),PKW(pB0,12),PKW(pB0,14)};pw2=(u32x4){PKW(pB1,0),PKW(pB1,2),PKW(pB1,4),PKW(pB1,6)};pw3=(u32x4){PKW(pB1,8),PKW(pB1,10),PKW(pB1,12),PKW(pB1,14)};
    SBAR(); pv(o,vb0+sl_cur,PAF(0),PAF(1),PAF(2),PAF(3)); }
  #undef PKW
  #undef PAF
  #undef VFR
  #undef PIN
  #undef MX3
  #undef GAPA
  #undef GAPB
  #undef EX
  #undef VRD
  #undef KRD
  #undef STEP
  #undef ENDW
  {auto rr=__builtin_amdgcn_permlane32_swap(__float_as_uint(l_reg),__float_as_uint(l_reg),false,false);l_reg=__uint_as_float(rr[0])+__uint_as_float(rr[1]);}
  if(hi==0)wsf[32+r32]=l_reg;asm volatile("s_waitcnt lgkmcnt(0)":::"memory");
  float rli[16];
  #pragma unroll
  for(int r=0;r<16;++r)rli[r]=__builtin_amdgcn_rcpf(wsf[32+crow(r,hi)]);
  bf16*Ow=O+qrow*OP+h*D;
  { bf16*stg=(bf16*)(shm+LDS_OST)+wid*2048;
    #pragma unroll
    for(int r=0;r<16;++r){const int orow=crow(r,hi);
      #pragma unroll
      for(int d0=0;d0<2;++d0)stg[orow*64+d0*32+r32]=__float2bfloat16(o[d0][r]*rli[r]);}
    asm volatile("s_waitcnt lgkmcnt(0)":::"memory");
    #pragma unroll
    for(int i=0;i<4;++i){const int row=i*8+(lane>>3),ch=lane&7; const u32x4 v=*(const u32x4*)(stg+row*64+ch*8); ATTN_STORE16(Ow+(long)row*OP+ch*8,v);} }
  asm volatile("s_waitcnt lgkmcnt(0)\n\ts_barrier":::"memory");
  #undef DMA_K
  #undef DMA_V
  #undef CMASK
  #undef START
  #undef RESC
  #undef ROT
}
constexpr int ATTN_LDS_BYTES=LDS_BYTES;
struct AttnTensors { const bf16* Q; const bf16* K; const bf16* V; bf16* O; };
struct AttnUnit { int bh; int qb; };
struct StaticOrder {
  int vcu;
  __device__ __forceinline__ explicit StaticOrder(int grid,int block):vcu((grid%8==0)?(block%8)*(grid/8)+block/8:block),G(grid){}
  int G;
  __device__ __forceinline__ bool next(int i,AttnUnit&u)const{ const int id=i*G+vcu; if(id>=BATCH*NHEAD*NQB)return false; u.bh=(id&255)>>3; u.qb=(id&7)+8*(id>>8); return true; }
  __device__ __forceinline__ void a_ready(const AttnUnit&)const{}
  __device__ __forceinline__ void done(const AttnUnit&)const{}
};
template<class Sched,int THRL=8> __device__ __forceinline__ void attn_phase(char*lds,const AttnTensors&T,const Sched&S){
  AttnUnit u;
  for(int i=0;S.next(i,u);++i){ S.a_ready(u); attn_unit<THRL>(u.bh/NHEAD,u.bh%NHEAD,u.qb,T.Q,T.K,T.V,T.O,lds); S.done(u); }
}
#undef SBAR
#undef WAIT_BAR
}
constexpr int NWAVES = 8;
constexpr int BATCH = 4, SEQ = 8192, D = 1024, CTXL = 256, NIN = 2816, FFH = 2816;
constexpr int ML = BATCH * SEQ;
constexpr int MC = BATCH * CTXL;
constexpr int MA = ML + MC;
constexpr int NCH = SEQ / 128, NCHA = NCH + 2;
constexpr float EPS = 1e-6f;
constexpr size_t MiB = 1u << 20;
constexpr size_t WS_CTL = 0, CTL_ZERO_BYTES = 64 * 1024;
constexpr size_t WS_WIN = 2 * MiB, WS_WOUT = 8 * MiB, WS_WF1 = 10 * MiB, WS_WF2 = 21 * MiB;
constexpr size_t WS_MOD = 27 * MiB;
constexpr size_t WS_COS = 28 * MiB, WS_SIN = 29 * MiB;
constexpr size_t WS_XN = 32 * MiB;
constexpr size_t WS_QA = 98 * MiB;
constexpr size_t WS_KA = 131 * MiB, WS_VA = 140 * MiB;
constexpr size_t WS_QR = 149 * MiB, WS_KR = 182 * MiB, WS_VR = 215 * MiB, WS_GR = 248 * MiB;
constexpr size_t WS_MIXIN = 281 * MiB;
constexpr size_t WS_L = 345 * MiB;
constexpr size_t WS_S = 411 * MiB;
constexpr size_t WS_MIXRAW = 98 * MiB;
constexpr size_t WS_HID = 98 * MiB;
constexpr size_t WS_FFNRAW = 281 * MiB;
constexpr size_t WS_END = 443 * MiB;
static_assert(WS_S + (size_t)32 * 64 * 2 * 4096 * 2 <= WS_END && WS_L + (size_t)32 * 66 * 2 * 4096 * 4 <= WS_S && WS_HID + (size_t)ML * FFH * 2 <= WS_FFNRAW && WS_FFNRAW + (size_t)ML * D * 4 <= WS_END, "d_ws map");
constexpr int RING_BYTES = 131072;
constexpr int MISC_OFF = RING_BYTES + 320;
constexpr int LDS_BYTES = 147456;

#define GAS __attribute__((address_space(1)))
#define LAS __attribute__((address_space(3)))
typedef unsigned short bf16;
typedef unsigned v4u __attribute__((ext_vector_type(4)));
typedef unsigned v2u __attribute__((ext_vector_type(2)));
typedef float f32x4 __attribute__((ext_vector_type(4)));
typedef short bf16x8 __attribute__((ext_vector_type(8)));
typedef short bf16x4 __attribute__((ext_vector_type(4)));
#define LDS_WAIT() asm volatile("s_waitcnt lgkmcnt(0)" ::: "memory")
__device__ __forceinline__ unsigned f2bf(float f) { unsigned u = __builtin_bit_cast(unsigned, f); return (u + 0x7fffu + ((u >> 16) & 1u)) >> 16; }
__device__ __forceinline__ unsigned pk2(float lo, float hi) { return f2bf(lo) | (f2bf(hi) << 16); }
__device__ __forceinline__ float bf2f(unsigned short b) { return __builtin_bit_cast(float, (unsigned)b << 16); }
__device__ __forceinline__ float wave_sum(float v) {
#pragma unroll
    for (int o = 1; o < 64; o <<= 1) v += __shfl_xor(v, o);
    return v;
}
#define XB_TMO      128
#define XB_XCNT(j)  (256  + 64 * (j))
#define XB_XSUB(j)  (1280 + 64 * (j))
#define XB_XGEN(j)  (2304 + 64 * (j))
#define XB_TOP      3328
#define XB_TOPGEN   3392
#define XCD_BAR_WORDS 3456
#define XB_SPIN_CAP (1u << 18)

__device__ __forceinline__ unsigned xb_ld(unsigned* p)              { return __hip_atomic_load(p, __ATOMIC_RELAXED, __HIP_MEMORY_SCOPE_AGENT); }
__device__ __forceinline__ unsigned xb_add(unsigned* p, unsigned v) { return __hip_atomic_fetch_add(p, v, __ATOMIC_RELAXED, __HIP_MEMORY_SCOPE_AGENT); }
__device__ __forceinline__ unsigned xb_xcc_id() { return (unsigned)__builtin_amdgcn_s_getreg((3 << 11) | 20) & 0xFu; }
#define XB_SPIN(cond, bar) do { unsigned _sp = 0; while (cond) { __builtin_amdgcn_s_sleep(1); \
    if ((++_sp & 255u) == 0u) { if (xb_ld(&(bar)[XB_TMO])) break; if (_sp > XB_SPIN_CAP) { atomicAdd(&(bar)[XB_TMO], 1u); break; } } } } while (0)

struct XcdBarrier {
    unsigned* bar; unsigned x;
    volatile LAS unsigned* st;
};

__device__ __forceinline__ XcdBarrier xcd_barrier_post(unsigned* bar, volatile LAS unsigned* st) {
    XcdBarrier b; b.bar = bar; b.x = xb_xcc_id(); b.st = st;
    if (threadIdx.x == 0) (void)xb_add(&bar[XB_XCNT(b.x)], 1u);
    return b;
}
__device__ __forceinline__ void xcd_barrier_complete(unsigned* bar, unsigned x, unsigned& nloc, unsigned& nx) {
    const unsigned G = gridDim.x * gridDim.y * gridDim.z;
    unsigned sum, cnt, mine, sp = 0u;
    for (;;) {
        sum = 0u; cnt = 0u; mine = 0u;
#pragma unroll
        for (unsigned j = 0; j < 16; ++j) { const unsigned c = xb_ld(&bar[XB_XCNT(j)]); sum += c; cnt += (c > 0u) ? 1u : 0u; mine = (j == x) ? c : mine; }
        if (sum == G) break;
        __builtin_amdgcn_s_sleep(1);
        if ((++sp & 255u) == 0u) { if (xb_ld(&bar[XB_TMO])) break; if (sp > XB_SPIN_CAP) { atomicAdd(&bar[XB_TMO], 1u); break; } }
    }
    nloc = mine > 0u ? mine : 1u; nx = cnt > 0u ? cnt : 1u;
}

__device__ __forceinline__ void xcd_barrier(const XcdBarrier& b) {
    asm volatile("s_waitcnt vmcnt(0)" ::: "memory");
    __syncthreads();
    if (threadIdx.x == 0) {
        unsigned* bar = b.bar;
        __builtin_amdgcn_s_waitcnt(0);
        unsigned nloc = b.st[0], nx = b.st[1];
        if (nloc == 0u) { xcd_barrier_complete(bar, b.x, nloc, nx); b.st[0] = nloc; b.st[1] = nx; }
        const unsigned old = xb_add(&bar[XB_XSUB(b.x)], 1u);
        const unsigned gen = old / nloc;
        if (old + 1u == (gen + 1u) * nloc) {
            __builtin_amdgcn_fence(__ATOMIC_RELEASE, "agent");
            asm volatile("s_waitcnt vmcnt(0)" ::: "memory");
            const unsigned og = xb_add(&bar[XB_TOP], 1u);
            const unsigned tg = og / nx;
            if (og + 1u == (tg + 1u) * nx) xb_add(&bar[XB_TOPGEN], 1u);
            else XB_SPIN(xb_ld(&bar[XB_TOPGEN]) == tg, bar);
            __builtin_amdgcn_fence(__ATOMIC_ACQUIRE, "agent");
            xb_add(&bar[XB_XGEN(b.x)], 1u);
            asm volatile("s_waitcnt vmcnt(0)" ::: "memory");
        } else {
            XB_SPIN(xb_ld(&bar[XB_XGEN(b.x)]) == gen, bar);
            __builtin_amdgcn_fence(__ATOMIC_ACQUIRE, "agent");
            asm volatile("s_waitcnt vmcnt(0)" ::: "memory");
        }
    }
    __syncthreads();
}

__device__ __forceinline__ int fresh_tid() { int t = threadIdx.x; asm volatile("" : "+v"(t)); return t; }
#define PHASE_IDS() const int tid = fresh_tid(), lane = tid & 63, wave = __builtin_amdgcn_readfirstlane(tid >> 6); (void)lane; (void)wave
struct Frame {
    LAS unsigned char* lds;
    int vcu, G;
    const float *x, *c, *ctx, *c_ctx, *w_mod, *b_mod, *g_pre_mix, *g_post_mix, *g_pre_ffn, *g_post_ffn, *w_in, *q_norm_g, *k_norm_g, *dec_f, *dec_b, *w_out, *w_f1, *w_f2;
    float* out; unsigned char* ws;
};
template <int MAP> __device__ __forceinline__ int wrow_map(int n) {
    if (MAP == 1) { const int t = n >> 8, l = n & 255; return (t << 8) + (((l >> 5) & 1) << 7) + ((l >> 6) << 5) + (l & 31); }
    if (MAP == 2) { const int half = n >= FFH ? 1 : 0, rem = n - half * FFH; return ((rem >> 7) << 8) + (half << 7) + (rem & 127); }
    return n;
}
template <int MAP> __device__ __forceinline__ void p0_transpose_item(const float* W, int K, int N, bf16* WT, LAS float* scr, int item, int lane) {
    const int nblk = N / 32, kb = item / nblk, nb = item % nblk, k0 = 64 * kb, n0 = 32 * nb;
#pragma unroll 8
    for (int i = 0; i < 32; ++i) { const int kk = 2 * i + (lane >> 5); scr[kk * 33 + (lane & 31)] = W[(size_t)(k0 + kk) * N + n0 + (lane & 31)]; }
    LDS_WAIT(); asm volatile("" ::: "memory");
    const int c = lane & 7;
#pragma unroll
    for (int j = 0; j < 4; ++j) { const int n = (lane >> 3) + 8 * j; const LAS float* s = scr + (8 * c) * 33 + n;
        v4u o; o.x = pk2(s[0 * 33], s[1 * 33]); o.y = pk2(s[2 * 33], s[3 * 33]); o.z = pk2(s[4 * 33], s[5 * 33]); o.w = pk2(s[6 * 33], s[7 * 33]);
        *(GAS v4u*)(WT + (size_t)wrow_map<MAP>(n0 + n) * K + k0 + 8 * c) = o; }
    LDS_WAIT(); asm volatile("" ::: "memory");
}
__device__ __forceinline__ float silu_f(float a) { return a / (1.0f + __expf(-a)); }
__device__ __forceinline__ void p0_prologue(Frame& F) {
    PHASE_IDS();
    LAS float* scr = (LAS float*)(F.lds + wave * 16384);
    const int gw = F.vcu * NWAVES + wave, NGW = F.G * NWAVES;
    constexpr int I_IN = (D / 64) * (NIN / 32), I_O = (D / 64) * (D / 32), I_1 = (D / 64) * (2 * FFH / 32), I_2 = (FFH / 64) * (D / 32), I_MOD = 96 * 16;
    constexpr int NITEMS = I_IN + I_O + I_1 + I_2 + I_MOD;
    for (int it = gw; it < NITEMS; it += NGW) {
        int r = it;
        if (r < I_MOD) {
            const int cb = r % 96, kc = r / 96, n = cb * 64 + lane, k0 = kc * 64;
            float a0 = 0.f, a1 = 0.f, a2 = 0.f, a3 = 0.f, a4 = 0.f;
            float sv[5];
#pragma unroll
            for (int q = 0; q < 5; ++q) { const float cv = q < 4 ? F.c[q * D + k0 + lane] : F.c_ctx[k0 + lane]; sv[q] = silu_f(cv); }
#pragma unroll 8
            for (int k = 0; k < 64; ++k) { const float w = F.w_mod[(size_t)(k0 + k) * 6144 + n];
                a0 += __shfl(sv[0], k) * w; a1 += __shfl(sv[1], k) * w; a2 += __shfl(sv[2], k) * w; a3 += __shfl(sv[3], k) * w; a4 += __shfl(sv[4], k) * w; }
            if (kc == 0) { const float bb = F.b_mod[n]; a0 += bb; a1 += bb; a2 += bb; a3 += bb; a4 += bb; }
            float* mod = (float*)(F.ws + WS_MOD);
            atomicAdd(mod + 0 * 6144 + n, a0); atomicAdd(mod + 1 * 6144 + n, a1); atomicAdd(mod + 2 * 6144 + n, a2); atomicAdd(mod + 3 * 6144 + n, a3); atomicAdd(mod + 4 * 6144 + n, a4);
            continue;
        } r -= I_MOD;
        if (r < I_IN) { p0_transpose_item<1>(F.w_in, D, NIN, (bf16*)(F.ws + WS_WIN), scr, r, lane); continue; } r -= I_IN;
        if (r < I_O) { p0_transpose_item<0>(F.w_out, D, D, (bf16*)(F.ws + WS_WOUT), scr, r, lane); continue; } r -= I_O;
        if (r < I_1) { p0_transpose_item<2>(F.w_f1, D, 2 * FFH, (bf16*)(F.ws + WS_WF1), scr, r, lane); continue; } r -= I_1;
        p0_transpose_item<0>(F.w_f2, FFH, D, (bf16*)(F.ws + WS_WF2), scr, r, lane);
    }
    float* cosT = (float*)(F.ws + WS_COS); float* sinT = (float*)(F.ws + WS_SIN);
    for (int e = (F.vcu * NWAVES * 64) + tid; e < SEQ * 32; e += F.G * NWAVES * 64) {
        const int pos = e >> 5, j = e & 31; const float p = (float)(j < 16 ? (pos >> 6) : (pos & 63));
        const float inv = powf(10000.0f, -(float)(j & 15) / 16.0f);
        const float ang = p * inv; cosT[e] = cosf(ang); sinT[e] = sinf(ang);
    }
}
__device__ __forceinline__ void p0b_rows(Frame& F) {
    PHASE_IDS();
    const int gw = F.vcu * NWAVES + wave, NGW = F.G * NWAVES;
    const float* mod = (const float*)(F.ws + WS_MOD); bf16* XN = (bf16*)(F.ws + WS_XN);
    for (int m = gw; m < MA; m += NGW) {
        const float* src = m < ML ? F.x + (size_t)m * D : F.ctx + (size_t)(m - ML) * D; const int mr = m < ML ? (m >> 13) : 4;
        const GAS f32x4* xr = (const GAS f32x4*)src + lane;
        f32x4 v[4]; float s = 0.f;
#pragma unroll
        for (int j = 0; j < 4; ++j) { v[j] = xr[64 * j]; s += (v[j].x * v[j].x + v[j].y * v[j].y) + (v[j].z * v[j].z + v[j].w * v[j].w); }
        const float rstd = 1.0f / sqrtf(wave_sum(s) * (1.f / D) + EPS);
        GAS v2u* o8 = (GAS v2u*)(XN + (size_t)m * D) + lane;
#pragma unroll
        for (int j = 0; j < 4; ++j) { const int col = 4 * lane + 256 * j;
            const f32x4 g = *(const f32x4*)(F.g_pre_mix + col), sh = *(const f32x4*)(mod + mr * 6144 + col), sc = *(const f32x4*)(mod + mr * 6144 + 1024 + col);
            const f32x4 y = (v[j] * rstd * g) * (sc + 1.0f) + sh;
            v2u w; w.x = pk2(y.x, y.y); w.y = pk2(y.z, y.w); o8[64 * j] = w; }
    }
}
__device__ __forceinline__ void p5_rows(Frame& F) {
    PHASE_IDS();
    const int gw = F.vcu * NWAVES + wave, NGW = F.G * NWAVES;
    const float* mod = (const float*)(F.ws + WS_MOD); bf16* HF = (bf16*)(F.ws + WS_XN); const float* MIX = (const float*)(F.ws + WS_MIXRAW);
    for (int m = gw; m < ML; m += NGW) {
        const int mr = m >> 13;
        const GAS f32x4* mrw = (const GAS f32x4*)(MIX + (size_t)m * D) + lane; const GAS f32x4* xr = (const GAS f32x4*)(F.x + (size_t)m * D) + lane;
        f32x4 v[4], xv[4]; float s = 0.f;
#pragma unroll
        for (int j = 0; j < 4; ++j) { v[j] = mrw[64 * j]; xv[j] = xr[64 * j]; s += (v[j].x * v[j].x + v[j].y * v[j].y) + (v[j].z * v[j].z + v[j].w * v[j].w); }
        const float rstd = 1.0f / sqrtf(wave_sum(s) * (1.f / D) + EPS);
        float s2 = 0.f;
        GAS f32x4* orow = (GAS f32x4*)(F.out + (size_t)m * D) + lane;
#pragma unroll
        for (int j = 0; j < 4; ++j) { const int col = 4 * lane + 256 * j;
            const f32x4 g = *(const f32x4*)(F.g_post_mix + col), gt = *(const f32x4*)(mod + mr * 6144 + 2048 + col);
            xv[j] = xv[j] + gt * (v[j] * rstd * g); orow[64 * j] = xv[j];
            s2 += (xv[j].x * xv[j].x + xv[j].y * xv[j].y) + (xv[j].z * xv[j].z + xv[j].w * xv[j].w); }
        const float rstd2 = 1.0f / sqrtf(wave_sum(s2) * (1.f / D) + EPS);
        GAS v2u* o8 = (GAS v2u*)(HF + (size_t)m * D) + lane;
#pragma unroll
        for (int j = 0; j < 4; ++j) { const int col = 4 * lane + 256 * j;
            const f32x4 g = *(const f32x4*)(F.g_pre_ffn + col), sh = *(const f32x4*)(mod + mr * 6144 + 3072 + col), sc = *(const f32x4*)(mod + mr * 6144 + 4096 + col);
            const f32x4 y = (xv[j] * rstd2 * g) * (sc + 1.0f) + sh;
            v2u w; w.x = pk2(y.x, y.y); w.y = pk2(y.z, y.w); o8[64 * j] = w; }
    }
}
__device__ __forceinline__ void p8_rows(Frame& F) {
    PHASE_IDS();
    const int gw = F.vcu * NWAVES + wave, NGW = F.G * NWAVES;
    const float* mod = (const float*)(F.ws + WS_MOD); const float* FFN = (const float*)(F.ws + WS_FFNRAW);
    for (int m = gw; m < ML; m += NGW) {
        const int mr = m >> 13;
        const GAS f32x4* fr = (const GAS f32x4*)(FFN + (size_t)m * D) + lane; GAS f32x4* orow = (GAS f32x4*)(F.out + (size_t)m * D) + lane;
        f32x4 v[4], xv[4]; float s = 0.f;
#pragma unroll
        for (int j = 0; j < 4; ++j) { v[j] = fr[64 * j]; xv[j] = orow[64 * j]; s += (v[j].x * v[j].x + v[j].y * v[j].y) + (v[j].z * v[j].z + v[j].w * v[j].w); }
        const float rstd = 1.0f / sqrtf(wave_sum(s) * (1.f / D) + EPS);
#pragma unroll
        for (int j = 0; j < 4; ++j) { const int col = 4 * lane + 256 * j;
            const f32x4 g = *(const f32x4*)(F.g_post_ffn + col), gt = *(const f32x4*)(mod + mr * 6144 + 5120 + col);
            orow[64 * j] = xv[j] + gt * (v[j] * rstd * g); }
    }
}
__device__ __forceinline__ float ret_lg2(const float* dec, int h) { return -1.4426950408889634f * __expf(dec[h]); }
constexpr int RT_STR = 136;
constexpr int RK_STR = 72;
__device__ __forceinline__ int ret_chunk_row(int b, int cc) { return cc < NCH ? b * SEQ + cc * 128 : ML + b * CTXL + (cc - NCH) * 128; }
__device__ __forceinline__ void ret_local_states(Frame& F) {
    PHASE_IDS();
    LAS bf16* Ktf = (LAS bf16*)F.lds; LAS bf16* Ktb = Ktf + 64 * RT_STR; LAS bf16* Vt = Ktb + 64 * RT_STR;
    const bf16* KR = (const bf16*)(F.ws + WS_KR); const bf16* VR = (const bf16*)(F.ws + WS_VR); float* Lb = (float*)(F.ws + WS_L);
    const int j = tid & 127, dq = (tid >> 7) * 16, l15 = lane & 15, quad = lane >> 4;
    for (int un = F.vcu; un < 32 * NCHA; un += F.G) {
        const int bh = un / NCHA, cc = un % NCHA, b = bh >> 3, h = bh & 7;
        const float lf2 = ret_lg2(F.dec_f, h), lb2 = ret_lg2(F.dec_b, h);
        const size_t grow = (size_t)(ret_chunk_row(b, cc) + j) * 512 + h * 64 + dq;
        const v4u k0 = *(const GAS v4u*)(KR + grow), k1 = *(const GAS v4u*)(KR + grow + 8), v0 = *(const GAS v4u*)(VR + grow), v1 = *(const GAS v4u*)(VR + grow + 8);
        const float df = __builtin_amdgcn_exp2f(lf2 * (float)(127 - j)), db = __builtin_amdgcn_exp2f(lb2 * (float)j);
        const unsigned kw[8] = {k0.x, k0.y, k0.z, k0.w, k1.x, k1.y, k1.z, k1.w}, vw[8] = {v0.x, v0.y, v0.z, v0.w, v1.x, v1.y, v1.z, v1.w};
#pragma unroll
        for (int e = 0; e < 8; ++e) {
            const float klo = __builtin_bit_cast(float, kw[e] << 16), khi = __builtin_bit_cast(float, kw[e] & 0xffff0000u);
            Ktf[(dq + 2 * e) * RT_STR + j] = (bf16)f2bf(klo * df); Ktf[(dq + 2 * e + 1) * RT_STR + j] = (bf16)f2bf(khi * df);
            Ktb[(dq + 2 * e) * RT_STR + j] = (bf16)f2bf(klo * db); Ktb[(dq + 2 * e + 1) * RT_STR + j] = (bf16)f2bf(khi * db);
            Vt[(dq + 2 * e) * RT_STR + j] = (bf16)(vw[e] & 0xffffu); Vt[(dq + 2 * e + 1) * RT_STR + j] = (bf16)(vw[e] >> 16);
        }
        __syncthreads();
        {
            const int dir = wave >> 2, et = wave & 3; LAS bf16* Kt = dir ? Ktb : Ktf;
            bf16x8 af[4];
#pragma unroll
            for (int ks = 0; ks < 4; ++ks) af[ks] = *(const LAS bf16x8*)(Vt + (16 * et + l15) * RT_STR + 32 * ks + quad * 8);
            float* dst = Lb + ((size_t)un * 2 + dir) * 4096;
#pragma unroll
            for (int dt = 0; dt < 4; ++dt) { f32x4 acc = {0.f, 0.f, 0.f, 0.f};
#pragma unroll
                for (int ks = 0; ks < 4; ++ks) { const bf16x8 bfr = *(const LAS bf16x8*)(Kt + (16 * dt + l15) * RT_STR + 32 * ks + quad * 8);
                    acc = __builtin_amdgcn_mfma_f32_16x16x32_bf16(af[ks], bfr, acc, 0, 0, 0); }
#pragma unroll
                for (int r = 0; r < 4; ++r) dst[(16 * et + quad * 4 + r) * 64 + 16 * dt + l15] = acc[r]; }
        }
        __syncthreads();
    }
}
__device__ __forceinline__ void ret_scan(Frame& F) {
    PHASE_IDS();
    const float* Lb = (const float*)(F.ws + WS_L); bf16* Sb = (bf16*)(F.ws + WS_S);
    for (int gid = F.vcu * NWAVES * 64 + tid; gid < 32 * 2 * 4096; gid += F.G * NWAVES * 64) {
        const int idx = gid & 4095, dir = (gid >> 12) & 1, bh = gid >> 13, h = bh & 7;
        const float G = __builtin_amdgcn_exp2f(128.0f * ret_lg2(dir ? F.dec_b : F.dec_f, h));
        const float* L = Lb + (size_t)bh * NCHA * 2 * 4096 + dir * 4096 + idx;
        bf16* S = Sb + (size_t)bh * NCH * 2 * 4096 + dir * 4096 + idx;
        float s;
        if (dir == 0) { s = L[(size_t)64 * 8192]; s = s * G + L[(size_t)65 * 8192];
#pragma unroll 8
            for (int c = 0; c < NCH; ++c) { S[(size_t)c * 8192] = (bf16)f2bf(s); s = s * G + L[(size_t)c * 8192]; } }
        else { s = L[(size_t)65 * 8192]; s = s * G + L[(size_t)64 * 8192];
#pragma unroll 8
            for (int c = NCH - 1; c >= 0; --c) { S[(size_t)c * 8192] = (bf16)f2bf(s); s = s * G + L[(size_t)c * 8192]; } }
    }
}
__device__ __forceinline__ void ret_outputs(Frame& F) {
    PHASE_IDS();
    LAS bf16* Kn = (LAS bf16*)F.lds; LAS bf16* Vt = Kn + 128 * RK_STR; LAS bf16* St = Vt + 64 * RT_STR;
    const bf16* QR = (const bf16*)(F.ws + WS_QR); const bf16* KR = (const bf16*)(F.ws + WS_KR); const bf16* VR = (const bf16*)(F.ws + WS_VR); const bf16* GR = (const bf16*)(F.ws + WS_GR);
    const bf16* Sb = (const bf16*)(F.ws + WS_S); bf16* MIX = (bf16*)(F.ws + WS_MIXIN);
    const int l15 = lane & 15, quad = lane >> 4, w = wave;
    for (int un = F.vcu; un < 32 * NCH; un += F.G) {
        const int bh = un / NCH, c = un % NCH, b = bh >> 3, h = bh & 7; const int R0 = b * SEQ + c * 128;
        const float lf2 = ret_lg2(F.dec_f, h), lb2 = ret_lg2(F.dec_b, h);
        { const int j = tid >> 2, part = (tid & 3) * 16; const size_t grow = (size_t)(R0 + j) * 512 + h * 64 + part;
          const v4u k0 = *(const GAS v4u*)(KR + grow), k1 = *(const GAS v4u*)(KR + grow + 8);
          *(LAS v4u*)(Kn + j * RK_STR + part) = k0; *(LAS v4u*)(Kn + j * RK_STR + part + 8) = k1; }
        { const int j = tid & 127, dq = (tid >> 7) * 16; const size_t grow = (size_t)(R0 + j) * 512 + h * 64 + dq;
          const v4u v0 = *(const GAS v4u*)(VR + grow), v1 = *(const GAS v4u*)(VR + grow + 8);
          const unsigned vw[8] = {v0.x, v0.y, v0.z, v0.w, v1.x, v1.y, v1.z, v1.w};
#pragma unroll
          for (int e = 0; e < 8; ++e) { Vt[(dq + 2 * e) * RT_STR + j] = (bf16)(vw[e] & 0xffffu); Vt[(dq + 2 * e + 1) * RT_STR + j] = (bf16)(vw[e] >> 16); } }
        { const bf16* Su = Sb + (size_t)un * 2 * 4096;
#pragma unroll
          for (int i = 0; i < 2; ++i) { const int p = tid + 512 * i, dir = p >> 9, e = (p >> 3) & 63, part = (p & 7) * 8;
              *(LAS v4u*)(St + (dir * 64 + e) * RK_STR + part) = *(const GAS v4u*)(Su + (size_t)dir * 4096 + e * 64 + part); } }
        bf16x8 qf[2];
#pragma unroll
        for (int ks = 0; ks < 2; ++ks) qf[ks] = *(const GAS bf16x8*)(QR + (size_t)(R0 + 16 * w + l15) * 512 + h * 64 + 32 * ks + quad * 8);
        __syncthreads();
        const int iloc = 16 * w + l15;
        bf16x8 pa[4];
#pragma unroll
        for (int kk = 0; kk < 4; ++kk) { unsigned pw[4];
#pragma unroll
            for (int half = 0; half < 2; ++half) { const int jt = 2 * kk + half; f32x4 st = {0.f, 0.f, 0.f, 0.f};
#pragma unroll
                for (int ks = 0; ks < 2; ++ks) { const bf16x8 kf = *(const LAS bf16x8*)(Kn + (16 * jt + l15) * RK_STR + 32 * ks + quad * 8);
                    st = __builtin_amdgcn_mfma_f32_16x16x32_bf16(kf, qf[ks], st, 0, 0, 0); }
                float pv[4];
#pragma unroll
                for (int r = 0; r < 4; ++r) { const int jj = 16 * jt + 4 * quad + r; const int diff = iloc - jj;
                    const float dfw = diff >= 0 ? __builtin_amdgcn_exp2f(lf2 * (float)diff) : 0.f, dbw = diff <= 0 ? __builtin_amdgcn_exp2f(lb2 * (float)(-diff)) : 0.f;
                    pv[r] = st[r] * (dfw + dbw); }
                pw[2 * half] = pk2(pv[0], pv[1]); pw[2 * half + 1] = pk2(pv[2], pv[3]); }
            pa[kk] = __builtin_bit_cast(bf16x8, (v4u){pw[0], pw[1], pw[2], pw[3]}); }
        f32x4 o[4];
#pragma unroll
        for (int dt = 0; dt < 4; ++dt) {
            f32x4 ai = {0.f, 0.f, 0.f, 0.f}, af = {0.f, 0.f, 0.f, 0.f}, ab = {0.f, 0.f, 0.f, 0.f};
#pragma unroll
            for (int kk = 0; kk < 4; ++kk) { const LAS bf16* vp = Vt + (16 * dt + l15) * RT_STR + 32 * kk + 4 * quad;
                const bf16x4 lo = *(const LAS bf16x4*)vp, hi = *(const LAS bf16x4*)(vp + 16);
                const bf16x8 vb = {lo[0], lo[1], lo[2], lo[3], hi[0], hi[1], hi[2], hi[3]};
                ai = __builtin_amdgcn_mfma_f32_16x16x32_bf16(pa[kk], vb, ai, 0, 0, 0); }
#pragma unroll
            for (int ks = 0; ks < 2; ++ks) { const bf16x8 sf = *(const LAS bf16x8*)(St + (16 * dt + l15) * RK_STR + 32 * ks + quad * 8), sb = *(const LAS bf16x8*)(St + (64 + 16 * dt + l15) * RK_STR + 32 * ks + quad * 8);
                af = __builtin_amdgcn_mfma_f32_16x16x32_bf16(qf[ks], sf, af, 0, 0, 0); ab = __builtin_amdgcn_mfma_f32_16x16x32_bf16(qf[ks], sb, ab, 0, 0, 0); }
#pragma unroll
            for (int r = 0; r < 4; ++r) { const int p = 16 * w + 4 * quad + r;
                o[dt][r] = ai[r] + __builtin_amdgcn_exp2f(lf2 * (float)(p + 1)) * af[r] + __builtin_amdgcn_exp2f(lb2 * (float)(128 - p)) * ab[r]; }
        }
#pragma unroll
        for (int r = 0; r < 4; ++r) {
            float s = (o[0][r] + o[1][r]) + (o[2][r] + o[3][r]);
            s += __shfl_xor(s, 1); s += __shfl_xor(s, 2); s += __shfl_xor(s, 4); s += __shfl_xor(s, 8);
            const float mu = s * (1.0f / 64.0f);
            const float d0 = o[0][r] - mu, d1 = o[1][r] - mu, d2 = o[2][r] - mu, d3 = o[3][r] - mu;
            float q = (d0 * d0 + d1 * d1) + (d2 * d2 + d3 * d3);
            q += __shfl_xor(q, 1); q += __shfl_xor(q, 2); q += __shfl_xor(q, 4); q += __shfl_xor(q, 8);
            const float rstd = 1.0f / sqrtf(q * (1.0f / 64.0f) + EPS);
            const size_t row = (size_t)(R0 + 16 * w + 4 * quad + r);
            const float dd[4] = {d0, d1, d2, d3};
#pragma unroll
            for (int dt = 0; dt < 4; ++dt) { const float g = bf2f(GR[row * 512 + h * 64 + 16 * dt + l15]);
                MIX[row * 1024 + 512 + h * 64 + 16 * dt + l15] = (bf16)f2bf(dd[dt] * rstd * (g / (1.0f + __expf(-g)))); }
        }
        __syncthreads();
    }
}
#ifndef REP_RL
#define REP_RL 1
#endif
#ifndef REP_RS
#define REP_RS 1
#endif
#ifndef REP_ATT
#define REP_ATT 1
#endif
#ifndef REP_RO
#define REP_RO 1
#endif
#ifndef REP_P5
#define REP_P5 1
#endif
#ifndef REP_P0B
#define REP_P0B 1
#endif
#ifndef REP_SYNC
#define REP_SYNC 0
#endif
struct Args { const float* in[18]; float* out; unsigned char* ws; };
__global__ void __launch_bounds__(NWAVES * 64, 2) hybrid_fwd(Args args) {
    extern __shared__ __attribute__((aligned(16))) unsigned char lds[];
    cg::grid_group grid = cg::this_grid();
    Frame F;
    F.lds = (LAS unsigned char*)lds;
    F.G = gridDim.x; { const int bx = blockIdx.x; F.vcu = (F.G % 8 == 0) ? (bx % 8) * (F.G / 8) + bx / 8 : bx; }
    F.x = args.in[0]; F.c = args.in[1]; F.ctx = args.in[2]; F.c_ctx = args.in[3]; F.w_mod = args.in[4]; F.b_mod = args.in[5];
    F.g_pre_mix = args.in[6]; F.g_post_mix = args.in[7]; F.g_pre_ffn = args.in[8]; F.g_post_ffn = args.in[9]; F.w_in = args.in[10];
    F.q_norm_g = args.in[11]; F.k_norm_g = args.in[12]; F.dec_f = args.in[13]; F.dec_b = args.in[14]; F.w_out = args.in[15]; F.w_f1 = args.in[16]; F.w_f2 = args.in[17];
    F.out = args.out; F.ws = args.ws;
    unsigned char* ws = args.ws;
    for (int u = threadIdx.x; u < (LDS_BYTES - RING_BYTES) / 4; u += NWAVES * 64) ((LAS unsigned*)(F.lds + RING_BYTES))[u] = 0u;
    __syncthreads();
    XcdBarrier bar = xcd_barrier_post((unsigned*)(ws + WS_CTL) + 1024, (volatile LAS unsigned*)(F.lds + MISC_OFF) + 8);
#define GRID_BAR() xcd_barrier(bar)

    p0_prologue(F);
    grid.sync();
    for (int rp = 0; rp < REP_P0B; ++rp) { p0b_rows(F);
    GRID_BAR(); }
    {
        pg8::Gemm g{(const pg8::bf16_t*)(ws + WS_XN), (const pg8::bf16_t*)(ws + WS_WIN), MA, NIN, D}; pg8::StaticOrder S; S.init(MA, NIN, F.G, (int)blockIdx.x);
        pg8::EpiInProj E{(pg8::bf16_t*)(ws + WS_QA), (pg8::bf16_t*)(ws + WS_KA), (pg8::bf16_t*)(ws + WS_VA), (pg8::bf16_t*)(ws + WS_QR), (pg8::bf16_t*)(ws + WS_KR), (pg8::bf16_t*)(ws + WS_VR), (pg8::bf16_t*)(ws + WS_GR),
                         F.q_norm_g, F.k_norm_g, (const float*)(ws + WS_COS), (const float*)(ws + WS_SIN), attn_body::C2};
        pg8::gemm_phase<pg8::EpiInProj, pg8::StaticOrder, true, true>(F.lds, g, S, E);
    }
    GRID_BAR();
    for (int rp = 0; rp < REP_RL; ++rp) { ret_local_states(F);
    GRID_BAR(); }
    for (int rp = 0; rp < REP_RS; ++rp) { ret_scan(F);
    GRID_BAR(); }
    {
        const attn_body::AttnTensors AT{(const attn_body::bf16*)(ws + WS_QA), (const attn_body::bf16*)(ws + WS_KA), (const attn_body::bf16*)(ws + WS_VA), (attn_body::bf16*)(ws + WS_MIXIN)};
        const attn_body::StaticOrder S((int)F.G, (int)blockIdx.x);
        for (int rp = 0; rp < REP_ATT; ++rp) attn_body::attn_phase<attn_body::StaticOrder>((char*)lds, AT, S);
        asm volatile("s_waitcnt vmcnt(0) lgkmcnt(0)" ::: "memory"); __syncthreads();
        for (int rp = 0; rp < REP_RO; ++rp) ret_outputs(F);
    }
    GRID_BAR();
    {
        pg8::Gemm g{(const pg8::bf16_t*)(ws + WS_MIXIN), (const pg8::bf16_t*)(ws + WS_WOUT), ML, D, D}; pg8::StaticOrder S; S.init(ML, D, F.G, (int)blockIdx.x);
        pg8::EpiF32 E{(float*)(ws + WS_MIXRAW), D};
        pg8::gemm_phase<pg8::EpiF32, pg8::StaticOrder, true, true>(F.lds, g, S, E);
    }
    GRID_BAR();
    for (int rp = 0; rp < REP_P5; ++rp) { p5_rows(F);
    GRID_BAR(); }
    {
        pg8::Gemm g{(const pg8::bf16_t*)(ws + WS_XN), (const pg8::bf16_t*)(ws + WS_WF1), ML, 2 * FFH, D}; pg8::StaticOrder S; S.init(ML, 2 * FFH, F.G, (int)blockIdx.x);
        pg8::EpiSwiglu E{(pg8::bf16_t*)(ws + WS_HID), FFH};
        pg8::gemm_phase<pg8::EpiSwiglu, pg8::StaticOrder, true, true>(F.lds, g, S, E);
    }
    GRID_BAR();
    {
        pg8::Gemm g{(const pg8::bf16_t*)(ws + WS_HID), (const pg8::bf16_t*)(ws + WS_WF2), ML, D, FFH}; pg8::StaticOrder S; S.init(ML, D, F.G, (int)blockIdx.x);
        pg8::EpiF32 E{(float*)(ws + WS_FFNRAW), D};
        pg8::gemm_phase<pg8::EpiF32, pg8::StaticOrder, true, true>(F.lds, g, S, E);
    }
    GRID_BAR();
    for (int rp = 0; rp < REP_SYNC; ++rp) GRID_BAR();
    p8_rows(F);
}

extern "C" void kernel_launch(void* const* d_in, const int* in_sizes, int n_in, void* d_out, int out_size, void* d_ws, size_t ws_size, hipStream_t stream) {
    static int grid = 0;
    if (grid == 0) {
        if (n_in != 18 || in_sizes[0] != ML * D || out_size != ML * D || ws_size < WS_END) { fprintf(stderr, "kernel_launch: unexpected shapes (n_in %d, in0 %d, out %d, ws %zu); nothing launched\n", n_in, n_in > 0 ? in_sizes[0] : -1, out_size, ws_size); grid = -1; return; }
        int dev = 0, cus = 0, per_cu = 0;
        if (hipGetDevice(&dev) != hipSuccess || hipDeviceGetAttribute(&cus, hipDeviceAttributeMultiprocessorCount, dev) != hipSuccess) { grid = -1; return; }
        if (hipFuncSetAttribute((const void*)hybrid_fwd, hipFuncAttributeMaxDynamicSharedMemorySize, LDS_BYTES) != hipSuccess) { fprintf(stderr, "kernel_launch: hipFuncSetAttribute failed\n"); grid = -1; return; }
        if (hipOccupancyMaxActiveBlocksPerMultiprocessor(&per_cu, (const void*)hybrid_fwd, NWAVES * 64, LDS_BYTES) != hipSuccess || per_cu < 1) { fprintf(stderr, "kernel_launch: occupancy query reports %d workgroups per CU\n", per_cu); (void)hipGetLastError(); grid = -1; return; }
        grid = cus * per_cu;
    }
    if (grid < 0) return;
    (void)hipMemsetAsync((char*)d_ws + WS_CTL, 0, CTL_ZERO_BYTES, stream);
    (void)hipMemsetAsync((char*)d_ws + WS_MOD, 0, 5 * 6144 * sizeof(float), stream);
    Args a{};
    for (int i = 0; i < 18; ++i) a.in[i] = (const float*)d_in[i];
    a.out = (float*)d_out; a.ws = (unsigned char*)d_ws;
    void* kargs[] = {&a};
    hipError_t e = hipLaunchCooperativeKernel((const void*)hybrid_fwd, dim3(grid), dim3(NWAVES * 64), kargs, LDS_BYTES, stream);
    if (e != hipSuccess) fprintf(stderr, "kernel_launch: cooperative launch failed: %s (grid %d)\n", hipGetErrorString(e), grid);
}
```
